# Optimizing an MI355X kernel written in HIP

```python
import math
import jax, jax.numpy as jnp
from jax import lax
import numpy as np

D_MODEL = 1024
BATCH = 2
SEQ = 8192
DEPTH = 1

ATTN_WIDTH = D_MODEL // 2
SSM_WIDTH = D_MODEL - ATTN_WIDTH
N_ATTN_HEADS = 4
ATTN_HEAD_DIM = ATTN_WIDTH // (2 * N_ATTN_HEADS)
V_HEAD_DIM = 2 * ATTN_HEAD_DIM
Q_BLOCK = 128
SSM_GROUP = 16
N_SSM_GROUPS = SSM_WIDTH // SSM_GROUP
SSM_STATE = 64
IN_WIDTH = 3 * ATTN_WIDTH + SSM_WIDTH
N_EXPERTS = 256
TOP_K = 8
N_EXPERT_GROUPS = 8
TOPK_GROUPS = 4
EXPERT_DIM = D_MODEL // 4
SHARED_DIM = EXPERT_DIM
ROUTED_SCALE = 2.5
EXPERT_BLOCK = 128
NORM_EPS = 1e-6
SUBLN_EPS = 1e-5
N_ADA = 6

kernel_name = "hybrid_diffattn_s5_moe_adaln"


def rms_norm(x, g, eps):
    xf = x.astype(jnp.float32)
    y = xf * lax.rsqrt(jnp.mean(xf * xf, axis=-1, keepdims=True) + eps)
    return (y * g.astype(jnp.float32)).astype(x.dtype)


def diff_attention(q, k, v, lam, lam_init, subln_g):
    bsz, seq = q.shape[0], q.shape[1]
    nb = seq // Q_BLOCK
    qb = (q * (ATTN_HEAD_DIM ** -0.5)).reshape(
        bsz, nb, Q_BLOCK, N_ATTN_HEADS, 2, ATTN_HEAD_DIM).swapaxes(0, 1)
    kpos = jnp.arange(seq)

    def block(args):
        qi, i = args
        s = jnp.einsum('bqhtd,bkhtd->bhtqk', qi, k, preferred_element_type=jnp.float32)
        qpos = i * Q_BLOCK + jnp.arange(Q_BLOCK)
        s = jnp.where(kpos[None, :] <= qpos[:, None], s, -jnp.inf)
        p = jax.nn.softmax(s, axis=-1)
        a = p[:, :, 0] - lam * p[:, :, 1]
        return jnp.einsum('bhqk,bkhe->bqhe', a.astype(v.dtype), v)

    o = lax.map(block, (qb, jnp.arange(nb)))
    o = o.swapaxes(0, 1).reshape(bsz, seq, N_ATTN_HEADS, V_HEAD_DIM)
    o = rms_norm(o, subln_g, SUBLN_EPS) * (1.0 - lam_init)
    return o.reshape(bsz, seq, ATTN_WIDTH)


def s5_mixer(u, a_re, a_im, log_step, b_re, b_im, c_re, c_im, d_skip, w_glu, b_glu):
    bsz, seq, _ = u.shape
    f32 = jnp.float32
    uf = u.astype(f32)
    ug = uf.reshape(bsz, seq, N_SSM_GROUPS, SSM_GROUP)
    lam = lax.complex(jnp.minimum(a_re.astype(f32), -1e-4), a_im.astype(f32))
    delta = jnp.exp(log_step.astype(f32))[:, None]
    lam_bar = jnp.exp(lam * delta)
    b_bar = ((lam_bar - 1.0) / lam)[:, :, None] * lax.complex(b_re.astype(f32), b_im.astype(f32))
    bu = jnp.einsum('blgc,gpc->blgp', ug.astype(jnp.complex64), b_bar)
    a = jnp.broadcast_to(lam_bar, bu.shape)

    def combine(e1, e2):
        a1, b1 = e1
        a2, b2 = e2
        return a1 * a2, a2 * b1 + b2

    _, states = lax.associative_scan(combine, (a, bu), axis=1)
    cmat = lax.complex(c_re.astype(f32), c_im.astype(f32))
    y = jnp.einsum('gcp,blgp->blgc', cmat, states).real.reshape(bsz, seq, SSM_WIDTH)
    y = y + d_skip.astype(f32) * uf
    g = jax.nn.gelu(y)
    out = g * jax.nn.sigmoid(g @ w_glu.astype(f32) + b_glu.astype(f32))
    return out.astype(u.dtype)


def moe(h, w_router, router_bias, w_gate, w_up, w_down, ws_gate, ws_up, ws_down):
    bsz, seq, dm = h.shape
    t = h.reshape(-1, dm)
    n_tok = t.shape[0]
    f32 = jnp.float32
    scores = jax.nn.sigmoid(jnp.dot(t, w_router, preferred_element_type=f32))
    sel = scores + router_bias.astype(f32)
    group_score = lax.top_k(sel.reshape(n_tok, N_EXPERT_GROUPS, -1), 2)[0].sum(-1)
    _, gidx = lax.top_k(group_score, TOPK_GROUPS)
    gmask = jnp.any(gidx[:, :, None] == jnp.arange(N_EXPERT_GROUPS)[None, None, :], axis=1)
    emask = jnp.repeat(gmask, N_EXPERTS // N_EXPERT_GROUPS, axis=1)
    _, idx = lax.top_k(jnp.where(emask, sel, -jnp.inf), TOP_K)
    w = jnp.take_along_axis(scores, idx, axis=-1)
    w = w / jnp.sum(w, axis=-1, keepdims=True) * ROUTED_SCALE

    nk = n_tok * TOP_K
    flat_e = idx.reshape(-1)
    flat_tok = jnp.arange(nk, dtype=jnp.int32) // TOP_K
    flat_w = w.reshape(-1)
    order = jnp.argsort(flat_e)
    se = flat_e[order]
    counts = jnp.bincount(flat_e, length=N_EXPERTS)
    pcounts = (counts + EXPERT_BLOCK - 1) // EXPERT_BLOCK * EXPERT_BLOCK
    starts = jnp.cumsum(counts) - counts
    pends = jnp.cumsum(pcounts)
    pstarts = pends - pcounts
    dest = pstarts[se] + jnp.arange(nk) - starts[se]
    n_blocks = -(-(nk + N_EXPERTS * (EXPERT_BLOCK - 1)) // EXPERT_BLOCK)
    n_rows = n_blocks * EXPERT_BLOCK
    buf_tok = jnp.zeros((n_rows,), jnp.int32).at[dest].set(flat_tok[order])
    buf_w = jnp.zeros((n_rows,), f32).at[dest].set(flat_w[order])
    blk_e = jnp.minimum(jnp.searchsorted(pends, jnp.arange(n_blocks) * EXPERT_BLOCK, side='right'),
                        N_EXPERTS - 1)

    def expert_block(args):
        tok, e = args
        xb = t[tok]
        hb = jax.nn.silu(xb @ w_gate[e]) * (xb @ w_up[e])
        return hb @ w_down[e]

    out = lax.map(expert_block, (buf_tok.reshape(n_blocks, EXPERT_BLOCK), blk_e))
    out = out.reshape(n_rows, dm) * buf_w[:, None].astype(out.dtype)
    routed = jax.ops.segment_sum(out, buf_tok, num_segments=n_tok)
    shared = (jax.nn.silu(t @ ws_gate) * (t @ ws_up)) @ ws_down
    return (routed + shared).reshape(bsz, seq, dm)


def setup_inputs(seed: int = 0) -> dict:
    key = jax.random.key(seed)
    ks = jax.random.split(key, 32)
    f32 = jnp.float32
    nrm = lambda k, shape, s: (jax.random.normal(k, shape, f32) * s)
    L_ = DEPTH
    a_im = jnp.broadcast_to(jnp.pi * jnp.arange(SSM_STATE, dtype=f32), (L_, N_SSM_GROUPS, SSM_STATE))
    return {
        "x": nrm(ks[0], (BATCH, SEQ, D_MODEL), 1.0),
        "c": nrm(ks[1], (BATCH, D_MODEL), 1.0),
        "w_ada": nrm(ks[2], (L_, D_MODEL, N_ADA * D_MODEL), 0.5 * D_MODEL ** -0.5),
        "b_ada": nrm(ks[3], (L_, N_ADA * D_MODEL), 0.02),
        "norm1_g": 1.0 + nrm(ks[4], (L_, D_MODEL), 0.02),
        "w_in": nrm(ks[5], (L_, D_MODEL, IN_WIDTH), D_MODEL ** -0.5),
        "w_out": nrm(ks[6], (L_, D_MODEL, D_MODEL), D_MODEL ** -0.5),
        "lambda_q1": nrm(ks[7], (L_, ATTN_HEAD_DIM), 0.1),
        "lambda_k1": nrm(ks[8], (L_, ATTN_HEAD_DIM), 0.1),
        "lambda_q2": nrm(ks[9], (L_, ATTN_HEAD_DIM), 0.1),
        "lambda_k2": nrm(ks[10], (L_, ATTN_HEAD_DIM), 0.1),
        "subln_g": 1.0 + nrm(ks[11], (L_, V_HEAD_DIM), 0.02),
        "ssm_a_re": -0.5 + nrm(ks[12], (L_, N_SSM_GROUPS, SSM_STATE), 0.01),
        "ssm_a_im": a_im + nrm(ks[13], (L_, N_SSM_GROUPS, SSM_STATE), 0.01),
        "ssm_log_step": jax.random.uniform(ks[14], (L_, N_SSM_GROUPS), f32, math.log(1e-3), math.log(1e-1)),
        "ssm_b_re": nrm(ks[15], (L_, N_SSM_GROUPS, SSM_STATE, SSM_GROUP), (2 * SSM_GROUP) ** -0.5),
        "ssm_b_im": nrm(ks[16], (L_, N_SSM_GROUPS, SSM_STATE, SSM_GROUP), (2 * SSM_GROUP) ** -0.5),
        "ssm_c_re": nrm(ks[17], (L_, N_SSM_GROUPS, SSM_GROUP, SSM_STATE), (2 * SSM_STATE) ** -0.5),
        "ssm_c_im": nrm(ks[18], (L_, N_SSM_GROUPS, SSM_GROUP, SSM_STATE), (2 * SSM_STATE) ** -0.5),
        "ssm_d": nrm(ks[19], (L_, SSM_WIDTH), 1.0),
        "w_glu": nrm(ks[20], (L_, SSM_WIDTH, SSM_WIDTH), SSM_WIDTH ** -0.5),
        "b_glu": nrm(ks[21], (L_, SSM_WIDTH), 0.02),
        "norm2_g": 1.0 + nrm(ks[22], (L_, D_MODEL), 0.02),
        "w_router": nrm(ks[23], (L_, D_MODEL, N_EXPERTS), D_MODEL ** -0.5),
        "router_bias": nrm(ks[24], (L_, N_EXPERTS), 0.01),
        "w_gate": nrm(ks[25], (L_, N_EXPERTS, D_MODEL, EXPERT_DIM), D_MODEL ** -0.5),
        "w_up": nrm(ks[26], (L_, N_EXPERTS, D_MODEL, EXPERT_DIM), D_MODEL ** -0.5),
        "w_down": nrm(ks[27], (L_, N_EXPERTS, EXPERT_DIM, D_MODEL), EXPERT_DIM ** -0.5),
        "ws_gate": nrm(ks[28], (L_, D_MODEL, SHARED_DIM), D_MODEL ** -0.5),
        "ws_up": nrm(ks[29], (L_, D_MODEL, SHARED_DIM), D_MODEL ** -0.5),
        "ws_down": nrm(ks[30], (L_, SHARED_DIM, D_MODEL), SHARED_DIM ** -0.5),
        "final_g": 1.0 + nrm(ks[31], (D_MODEL,), 0.02),
    }


def reference(x, c, w_ada, b_ada, norm1_g, w_in, w_out, lambda_q1, lambda_k1, lambda_q2,
              lambda_k2, subln_g, ssm_a_re, ssm_a_im, ssm_log_step, ssm_b_re, ssm_b_im,
              ssm_c_re, ssm_c_im, ssm_d, w_glu, b_glu, norm2_g, w_router, router_bias,
              w_gate, w_up, w_down, ws_gate, ws_up, ws_down, final_g):
    bsz, seq, _ = x.shape
    f32 = jnp.float32
    cond = jax.nn.silu(c)
    for l in range(DEPTH):
        mod = (cond @ w_ada[l] + b_ada[l])[:, None, :]
        shift1, scale1, gate1, shift2, scale2, gate2 = jnp.split(mod, N_ADA, axis=-1)

        h = rms_norm(x, norm1_g[l], NORM_EPS) * (1.0 + scale1) + shift1
        proj = h @ w_in[l]
        q, k, v, u = jnp.split(proj, [ATTN_WIDTH, 2 * ATTN_WIDTH, 3 * ATTN_WIDTH], axis=-1)
        q = q.reshape(bsz, seq, N_ATTN_HEADS, 2, ATTN_HEAD_DIM)
        k = k.reshape(bsz, seq, N_ATTN_HEADS, 2, ATTN_HEAD_DIM)
        v = v.reshape(bsz, seq, N_ATTN_HEADS, V_HEAD_DIM)
        lam_init = 0.8 - 0.6 * math.exp(-0.3 * l)
        lam = (jnp.exp(jnp.sum(lambda_q1[l].astype(f32) * lambda_k1[l].astype(f32)))
               - jnp.exp(jnp.sum(lambda_q2[l].astype(f32) * lambda_k2[l].astype(f32))) + lam_init)
        attn_out = diff_attention(q, k, v, lam, lam_init, subln_g[l])
        ssm_out = s5_mixer(u, ssm_a_re[l], ssm_a_im[l], ssm_log_step[l], ssm_b_re[l], ssm_b_im[l],
                           ssm_c_re[l], ssm_c_im[l], ssm_d[l], w_glu[l], b_glu[l])
        mix = jnp.concatenate([attn_out, ssm_out], axis=-1) @ w_out[l]
        x = x + gate1 * mix

        h2 = rms_norm(x, norm2_g[l], NORM_EPS) * (1.0 + scale2) + shift2
        x = x + gate2 * moe(h2, w_router[l], router_bias[l], w_gate[l], w_up[l], w_down[l],
                            ws_gate[l], ws_up[l], ws_down[l])
    return rms_norm(x, final_g, NORM_EPS)
```

```cpp
#include <hip/hip_runtime.h>
#include <hip/hip_bf16.h>
#include <cstdio>
#include <cstdint>
#include <cmath>
namespace nv {
template <int CS = 1> __device__ __forceinline__ void route_token(const float* lrow, const float* rbias, int lane, int* idx_out, float* w_out, unsigned* counts) {
    float v[4], s[4];
    { float4 lg = *(const float4*)(lrow + lane * 4); float4 rb = *(const float4*)(rbias + lane * 4);
      v[0] = 1.f / (1.f + __expf(-lg.x)); v[1] = 1.f / (1.f + __expf(-lg.y)); v[2] = 1.f / (1.f + __expf(-lg.z)); v[3] = 1.f / (1.f + __expf(-lg.w));
      s[0] = v[0] + rb.x; s[1] = v[1] + rb.y; s[2] = v[2] + rb.z; s[3] = v[3] + rb.w; }
    float m1 = fmaxf(s[0], s[1]), m2 = fminf(s[0], s[1]);
    { float a = fmaxf(s[2], s[3]), bb = fminf(s[2], s[3]); float n1 = fmaxf(m1, a); float n2 = fmaxf(fminf(m1, a), fmaxf(m2, bb)); m1 = n1; m2 = n2; }
#pragma unroll
    for (int o = 1; o < 8; o <<= 1) { float a1 = __shfl_xor(m1, o), a2 = __shfl_xor(m2, o); float n1 = fmaxf(m1, a1); float n2 = fmaxf(fminf(m1, a1), fmaxf(m2, a2)); m1 = n1; m2 = n2; }
    const float gs = m1 + m2; const int mygrp = lane >> 3;
    int rank = 0;
#pragma unroll
    for (int gq = 0; gq < 8; ++gq) { float og = __shfl(gs, gq * 8); rank += (og > gs || (og == gs && gq < mygrp)) ? 1 : 0; }
    const bool sel = rank < 4;
#pragma unroll
    for (int i = 0; i < 4; ++i) if (!sel) s[i] = -INFINITY;
    float wsum = 0.f; float myw = 0.f; int myidx = 0;
#pragma unroll
    for (int k = 0; k < 8; ++k) {
        float bv = s[0]; int bi = 0;
#pragma unroll
        for (int i = 1; i < 4; ++i) if (s[i] > bv) { bv = s[i]; bi = i; }
        int be = lane * 4 + bi;
#pragma unroll
        for (int o = 1; o < 64; o <<= 1) { float ov = __shfl_xor(bv, o); int oe = __shfl_xor(be, o); if (ov > bv || (ov == bv && oe < be)) { bv = ov; be = oe; } }
        const int wl = be >> 2, wi = be & 3;
        float vsel = (wi == 0) ? v[0] : (wi == 1) ? v[1] : (wi == 2) ? v[2] : v[3];
        vsel = __shfl(vsel, wl);
        if (lane == wl) { if (wi == 0) s[0] = -INFINITY; else if (wi == 1) s[1] = -INFINITY; else if (wi == 2) s[2] = -INFINITY; else s[3] = -INFINITY; }
        wsum += vsel; if (lane == k) { myw = vsel; myidx = be; }
    }
    if (lane < 8) { idx_out[lane] = myidx; w_out[lane] = myw / wsum * 2.5f; atomicAdd(&counts[myidx * CS], 1u); }
}
__device__ __forceinline__ unsigned umax_(unsigned a, unsigned b) { return a > b ? a : b; }
__device__ __forceinline__ unsigned wave_umax_dpp(unsigned k) {
#ifdef EXP_SHFL_MAX
    for (int o = 1; o < 64; o <<= 1) k = umax_(k, (unsigned)__shfl_xor((int)k, o));
    return (unsigned)__builtin_amdgcn_readfirstlane((int)k);
#endif
    k = umax_(k, (unsigned)__builtin_amdgcn_update_dpp(0, (int)k, 0x111, 0xf, 0xf, false));
    k = umax_(k, (unsigned)__builtin_amdgcn_update_dpp(0, (int)k, 0x112, 0xf, 0xf, false));
    k = umax_(k, (unsigned)__builtin_amdgcn_update_dpp(0, (int)k, 0x114, 0xf, 0xf, false));
    k = umax_(k, (unsigned)__builtin_amdgcn_update_dpp(0, (int)k, 0x118, 0xf, 0xf, false));
    k = umax_(k, (unsigned)__builtin_amdgcn_update_dpp(0, (int)k, 0x142, 0xa, 0xf, false));
    k = umax_(k, (unsigned)__builtin_amdgcn_update_dpp(0, (int)k, 0x143, 0xc, 0xf, false));
    return (unsigned)__builtin_amdgcn_readlane((int)k, 63);
}
__device__ __forceinline__ unsigned fkey(float f) { const unsigned u = __float_as_uint(f); return u ^ ((u >> 31) ? 0xffffffffu : 0x80000000u); }
template <int CS, bool COUNT = true> __device__ __forceinline__ void route_token_dpp(const float* lrow, const float* rbias, int lane, int* idx_out, float* w_out, unsigned* counts, int* rank_out = nullptr, int* list_out = nullptr, int token = 0) {
    float v[4], s[4];
    { const float4 lg = *(const float4*)(lrow + lane * 4); const float4 rb = *(const float4*)(rbias + lane * 4);
      v[0] = 1.f / (1.f + __expf(-lg.x)); v[1] = 1.f / (1.f + __expf(-lg.y)); v[2] = 1.f / (1.f + __expf(-lg.z)); v[3] = 1.f / (1.f + __expf(-lg.w));
      s[0] = v[0] + rb.x; s[1] = v[1] + rb.y; s[2] = v[2] + rb.z; s[3] = v[3] + rb.w; }
    float m1 = fmaxf(s[0], s[1]), m2 = fminf(s[0], s[1]);
    { const float a = fmaxf(s[2], s[3]), bb = fminf(s[2], s[3]); const float n1 = fmaxf(m1, a), n2 = fmaxf(fminf(m1, a), fmaxf(m2, bb)); m1 = n1; m2 = n2; }
#pragma unroll
    for (int o = 1; o < 8; o <<= 1) { const float a1 = __shfl_xor(m1, o), a2 = __shfl_xor(m2, o); const float n1 = fmaxf(m1, a1), n2 = fmaxf(fminf(m1, a1), fmaxf(m2, a2)); m1 = n1; m2 = n2; }
    const float gs = m1 + m2; const int mygrp = lane >> 3; int rank = 0;
#pragma unroll
    for (int gq = 0; gq < 8; ++gq) { const float og = __int_as_float(__builtin_amdgcn_readlane(__float_as_int(gs), gq * 8)); rank += (og > gs || (og == gs && gq < mygrp)) ? 1 : 0; }
    unsigned key[4];
#pragma unroll
    for (int i = 0; i < 4; ++i) key[i] = (rank < 4) ? fkey(s[i]) : 0u;
    float wsum = 0.f, myw = 0.f; int myidx = 0;
#pragma unroll
    for (int k = 0; k < 8; ++k) {
        unsigned bk = key[0]; int bi = 0;
#pragma unroll
        for (int i = 1; i < 4; ++i) if (key[i] > bk) { bk = key[i]; bi = i; }
        const unsigned mk = wave_umax_dpp(bk);
        const unsigned long long bal = __ballot(bk == mk);
        const int wl = __builtin_amdgcn_readfirstlane((int)__builtin_ctzll(bal));
        const int wi = __builtin_amdgcn_readlane(bi, wl);
        const float vsel0 = (wi == 0) ? v[0] : (wi == 1) ? v[1] : (wi == 2) ? v[2] : v[3];
        const float vsel = __int_as_float(__builtin_amdgcn_readlane(__float_as_int(vsel0), wl));
        { const bool me = (lane == wl);
#pragma unroll
          for (int i = 0; i < 4; ++i) key[i] = (me && wi == i) ? 0u : key[i]; }
        wsum += vsel; if (lane == k) { myw = vsel; myidx = wl * 4 + wi; }
    }
    if (lane < 8) { idx_out[lane] = myidx; w_out[lane] = myw / wsum * 2.5f; if (COUNT) { const unsigned rk = atomicAdd(&counts[myidx * CS], 1u); if (rank_out) rank_out[lane] = (int)rk; if (list_out) list_out[myidx * 16384 + (int)rk] = token; } }
}
}
namespace pg8 {
#define PG8_LAS __attribute__((address_space(3)))
typedef unsigned short bf16_t;
typedef short bf16x8 __attribute__((ext_vector_type(8)));
typedef float f32x4 __attribute__((ext_vector_type(4)));
typedef float f32x2 __attribute__((ext_vector_type(2)));
typedef unsigned u32x4 __attribute__((ext_vector_type(4)));
typedef unsigned u32x2 __attribute__((ext_vector_type(2)));
constexpr int BM = 256, BK = 64, HALF = 128, HTB = HALF * BK * 2  , STAGE_BYTES = 8 * HTB;

__host__ __device__ __forceinline__ int lds_x(int r, int k) { return r * 128 + ((((k >> 3) ^ r) & 7) << 4) + (k & 7) * 2; }
__host__ __device__ __forceinline__ int lds_byte(int r, int c) { const int st = (r >> 4) * 2 + (c >> 5), rr = r & 15, cc = c & 31, ob = rr * 64 + cc * 2; return st * 1024 + (ob ^ (((ob >> 9) & 1) << 5)); }
__host__ __device__ __forceinline__ void stage_rc(int b, int& R, int& C) { const int st = b / 1024, sb = b % 1024, swz = sb ^ (((sb >> 9) & 1) << 5); R = (st >> 1) * 16 + swz / 64; C = (st & 1) * 32 + (swz % 64) / 2; }
__host__ __device__ __forceinline__ int perm32(int rho) { const int n = rho >> 4, i = rho & 15; return 8 * (i >> 2) + 4 * n + (i & 3); }

struct Unit { const char* A; const char* B; const int* gath; int pm, pn, r0, nv; };

__device__ __forceinline__ unsigned cvt_pk_bf16(float lo, float hi) { unsigned r; asm volatile("v_cvt_pk_bf16_f32 %0, %1, %2" : "=v"(r) : "v"(lo), "v"(hi)); return r; }

template <class E, class = void> struct has_p16 { static constexpr bool v = false; };
template <class E> struct has_p16<E, decltype((void)E::PERM16)> { static constexpr bool v = E::PERM16; };
template <class Epi, class Sched, bool GATHER, bool ALIGN_EPI, bool FP8 = false>
__device__ __forceinline__ void gemm_phase(PG8_LAS unsigned char* lds, const int K, const int lda, const int ldb, const Sched& S, const Epi& E) {
    int tid_ = threadIdx.x; asm volatile("" : "+v"(tid_));
    const int tid = tid_, wid = __builtin_amdgcn_readfirstlane(tid >> 6), lane = tid & 63, wr = wid >> 2, wc = wid & 3, fr = lane & 15, fq = lane >> 4;
    const int nt = K / BK;
    unsigned voffA[2][2], voffB[2];
#pragma unroll
    for (int i = 0; i < 2; ++i) { const int R = 8 * wid + 64 * i + (lane >> 3), C = 8 * ((lane ^ (lane >> 3)) & 7); const int Rb = has_p16<Epi>::v ? (64 * (R >> 5) + 16 * ((R & 15) >> 2) + 4 * ((R >> 4) & 1) + (R & 3)) : Epi::PERM ? ((R & ~31) + perm32(R & 31)) : R;
        voffA[0][i] = (unsigned)(R * lda + C) * 2u; voffA[1][i] = (unsigned)((R + HALF) * lda + C) * 2u; voffB[i] = (unsigned)(Rb * ldb + C) * 2u; }
    const size_t kstep = (size_t)(BK * 2);
    const size_t hstepB = (size_t)(has_p16<Epi>::v ? 8 : HALF) * ldb * 2;
    const unsigned ldsw = (unsigned)wid * 1024u;
    const int aoff0 = lds_x(wr * 64 + fr, fq * 8), aoff1 = aoff0 ^ 64, boff0 = lds_x(wc * 32 + fr, fq * 8), boff1 = boff0 ^ 64;
#define PG8_SA(b, h) (((b) * 2 + (h)) * HTB)
#define PG8_SB(b, h) ((4 + (b) * 2 + (h)) * HTB)
#define PG8_STAGE(bufoff, gbase, voff) do { _Pragma("unroll") for (int _i = 0; _i < 2; ++_i) \
        __builtin_amdgcn_global_load_lds((const unsigned*)((const char*)(gbase) + (voff)[_i]), (PG8_LAS unsigned*)(lds + (bufoff) + ldsw + _i * 8192), 16, 0, 0); } while (0)
#define PG8_LDA(dst, b, h) do { _Pragma("unroll") for (int m = 0; m < 4; ++m) _Pragma("unroll") for (int k = 0; k < 2; ++k) dst[m][k] = *(const PG8_LAS bf16x8*)(lds + PG8_SA(b, h) + (k ? aoff1 : aoff0) + m * 2048); } while (0)
#define PG8_LDB(dst, b, h) do { _Pragma("unroll") for (int n = 0; n < 2; ++n) _Pragma("unroll") for (int k = 0; k < 2; ++k) dst[n][k] = *(const PG8_LAS bf16x8*)(lds + PG8_SB(b, h) + (k ? boff1 : boff0) + n * 2048); } while (0)
#define PG8_MMA(ai, bj, At, Bt) do { __builtin_amdgcn_s_setprio(1); _Pragma("unroll") for (int m = 0; m < 4; ++m) _Pragma("unroll") for (int n = 0; n < 2; ++n) _Pragma("unroll") for (int k = 0; k < 2; ++k) { \
        if constexpr (FP8) { typedef long l2_ __attribute__((ext_vector_type(2))); const l2_ b_ = __builtin_bit_cast(l2_, Bt[n][k]), a_ = __builtin_bit_cast(l2_, At[m][k]);     \
            acc[ai][bj][m][n] = __builtin_amdgcn_mfma_f32_16x16x32_fp8_fp8(b_.x, a_.x, acc[ai][bj][m][n], 0, 0, 0); acc[ai][bj][m][n] = __builtin_amdgcn_mfma_f32_16x16x32_fp8_fp8(b_.y, a_.y, acc[ai][bj][m][n], 0, 0, 0); } \
        else acc[ai][bj][m][n] = __builtin_amdgcn_mfma_f32_16x16x32_bf16(Bt[n][k], At[m][k], acc[ai][bj][m][n], 0, 0, 0); } __builtin_amdgcn_s_setprio(0); } while (0)
#define PG8_WAIT_V(n) asm volatile("s_waitcnt vmcnt(" #n ")" ::: "memory")
#define PG8_WAIT_L(n) asm volatile("s_waitcnt lgkmcnt(" #n ")" ::: "memory")
#define PG8_BAR __builtin_amdgcn_s_barrier()
#define PG8_SCHED __builtin_amdgcn_sched_barrier(0)
#define PG8_GATH(gp) do { if constexpr (GATHER) { _Pragma("unroll") for (int _i = 0; _i < 2; ++_i) { const int R_ = 8 * wid + 64 * _i + (lane >> 3), C_ = 8 * ((lane ^ (lane >> 3)) & 7); \
        voffA[0][_i] = (unsigned)(((gp)[R_] & 16383) * lda + C_) * 2u; voffA[1][_i] = (unsigned)(((gp)[R_ + HALF] & 16383) * lda + C_) * 2u; } } } while (0)
    Unit cur, nxt; int ui = 0;
    if (!S.next(0, cur)) return;
    f32x4 acc[2][2][4][2];
#pragma unroll
    for (int a = 0; a < 2; ++a)
#pragma unroll
        for (int b = 0; b < 2; ++b)
#pragma unroll
            for (int m = 0; m < 4; ++m)
#pragma unroll
                for (int n = 0; n < 2; ++n) acc[a][b][m][n] = (f32x4){0.f, 0.f, 0.f, 0.f};
    bf16x8 At[4][2], B0[2][2], B1[2][2];
    const char* cA = cur.A; const char* cB = cur.B;
    PG8_GATH(cur.gath);
    PG8_STAGE(PG8_SB(0, 0), cB, voffB); PG8_STAGE(PG8_SB(0, 1), cB + hstepB, voffB); PG8_STAGE(PG8_SA(0, 0), cA, voffA[0]); PG8_STAGE(PG8_SA(0, 1), cA, voffA[1]);
    if (wr == 1) PG8_BAR;
    PG8_WAIT_V(2); PG8_BAR;
    PG8_STAGE(PG8_SB(1, 0), cB + kstep, voffB); PG8_STAGE(PG8_SA(1, 0), cA + kstep, voffA[0]); PG8_STAGE(PG8_SB(1, 1), cB + hstepB + kstep, voffB);
    PG8_WAIT_V(6); PG8_BAR;
    for (;;) {
        const bool has_next = S.next(ui + 1, nxt);
        const char* nA = has_next ? nxt.A : cA; const char* nB = has_next ? nxt.B : cB;
#pragma unroll 1
        for (int t = 0; t < nt; t += 2) {
            const bool last = (t == nt - 2);
            const char* a1 = cA + (size_t)(t + 1) * kstep;
            const char* a2 = last ? nA : cA + (size_t)(t + 2) * kstep; const char* b2 = last ? nB : cB + (size_t)(t + 2) * kstep;
            const char* a3 = a2 + kstep; const char* b3 = b2 + kstep;
            PG8_LDB(B0, 0, 0); PG8_LDB(B1, 0, 1); PG8_SCHED; PG8_LDA(At, 0, 0); PG8_STAGE(PG8_SA(1, 1), a1, voffA[1]);
            if constexpr (GATHER) { if (last && has_next) { PG8_GATH(nxt.gath); } }
            PG8_WAIT_V(8); PG8_WAIT_L(0); PG8_BAR; PG8_MMA(0, 0, At, B0); PG8_MMA(0, 1, At, B1); PG8_BAR; PG8_SCHED;
            PG8_LDA(At, 0, 1); PG8_STAGE(PG8_SB(0, 0), b2, voffB); PG8_STAGE(PG8_SB(0, 1), b2 + hstepB, voffB); PG8_STAGE(PG8_SA(0, 0), a2, voffA[0]);
            PG8_WAIT_V(8); PG8_WAIT_L(0); PG8_BAR; PG8_MMA(1, 0, At, B0); PG8_MMA(1, 1, At, B1); PG8_BAR; PG8_SCHED;
            PG8_LDB(B0, 1, 0); PG8_LDB(B1, 1, 1); PG8_SCHED; PG8_LDA(At, 1, 0); PG8_STAGE(PG8_SA(0, 1), a2, voffA[1]);
            PG8_WAIT_V(8); PG8_WAIT_L(0); PG8_BAR; PG8_MMA(0, 0, At, B0); PG8_MMA(0, 1, At, B1); PG8_BAR; PG8_SCHED;
            PG8_LDA(At, 1, 1); PG8_STAGE(PG8_SB(1, 0), b3, voffB); PG8_STAGE(PG8_SB(1, 1), b3 + hstepB, voffB); PG8_STAGE(PG8_SA(1, 0), a3, voffA[0]);
            PG8_WAIT_V(8); PG8_WAIT_L(0); PG8_BAR; PG8_MMA(1, 0, At, B0); PG8_MMA(1, 1, At, B1); PG8_BAR; PG8_SCHED;
        }
        if constexpr (ALIGN_EPI) { if (wr == 0) PG8_BAR; }
        E(acc, cur, wr, wc, fr, fq);
        if (!has_next) break;
#pragma unroll
        for (int a = 0; a < 2; ++a)
#pragma unroll
            for (int b = 0; b < 2; ++b)
#pragma unroll
                for (int m = 0; m < 4; ++m)
#pragma unroll
                    for (int n = 0; n < 2; ++n) acc[a][b][m][n] = (f32x4){0.f, 0.f, 0.f, 0.f};
        cur = nxt; cA = nA; cB = nB; ++ui;
        if constexpr (ALIGN_EPI) { if (wr == 1) PG8_BAR; }
    }
    PG8_WAIT_V(0);
    if constexpr (!ALIGN_EPI) { if (wr == 0) PG8_BAR; }
    PG8_BAR;
#undef PG8_SA
#undef PG8_SB
#undef PG8_STAGE
#undef PG8_LDA
#undef PG8_LDB
#undef PG8_MMA
#undef PG8_WAIT_V
#undef PG8_WAIT_L
#undef PG8_BAR
#undef PG8_SCHED
#undef PG8_GATH
}
}
namespace mg {
using pg8::bf16x8; using pg8::f32x4; using pg8::u32x4; using pg8::u32x2; using pg8::lds_byte; using pg8::stage_rc; using pg8::perm32; using pg8::cvt_pk_bf16;
#define MG_LAS __attribute__((address_space(3)))
#define MG_GAS __attribute__((address_space(1)))
constexpr int HTB = 16384;
__device__ __forceinline__ int lds_x(int r, int k) { return r * 128 + ((((k >> 3) ^ r) & 7) << 4) + (k & 7) * 2; }
constexpr int LDS_A = 0, LDS_B = 6 * HTB, STAGE_BYTES = 8 * HTB;
struct Unit { const char* A; const float* B0; const float* B1; const int* gath; int pm, pn, r0, nv; };

struct BMapPerm {
    static __device__ __forceinline__ const float* src(const Unit& u, int R4) { return u.B0 + (R4 & ~31) + perm32(R4 & 31); } };
struct BMapGateUp {
    static __device__ __forceinline__ const float* src(const Unit& u, int R4) { const int blk = R4 >> 4; return ((blk & 1) ? u.B1 : u.B0) + (blk >> 1) * 16 + (R4 & 15); } };

template <class Epi, class Sched, class BMap, bool GATHER>
__device__ __forceinline__ void gemm_phase(MG_LAS unsigned char* lds, const int K, const int lda, const int ldw, const Sched& S, const Epi& E) {
    int tid_ = threadIdx.x; asm volatile("" : "+v"(tid_));
    const int tid = tid_, wid = __builtin_amdgcn_readfirstlane(tid >> 6), lane = tid & 63, wr = wid >> 2, wc = wid & 3, fr = lane & 15, fq = lane >> 4;
    const int nt = K / 64;
    unsigned voffA[2][2];
#pragma unroll
    for (int i = 0; i < 2; ++i) { const int R = 8 * wid + 64 * i + (lane >> 3), C = 8 * ((lane ^ (lane >> 3)) & 7); voffA[0][i] = (unsigned)(R * lda + C) * 2u; voffA[1][i] = (unsigned)((R + 128) * lda + C) * 2u; }
    const unsigned ldsw = (unsigned)wid * 1024u;
    const int aoff0 = lds_x(wr * 64 + fr, fq * 8), aoff1 = aoff0 ^ 64, boff0 = lds_x(wc * 32 + fr, fq * 8), boff1 = boff0 ^ 64;
    const int kh = lane & 1, kc = ((lane >> 1) & 3) | ((wid & 1) << 2), ng = ((lane >> 3) & 7) | ((wid >> 1) << 3);
    const int brow = 8 * kc + 4 * kh;
    unsigned bwr[4];
#pragma unroll
    for (int i = 0; i < 4; ++i) bwr[i] = (unsigned)lds_x(4 * ng + i, brow);
    const size_t kstepA = 128, kstepB = (size_t)64 * ldw;
#define MG_SA(s, h) (LDS_A + ((s) * 2 + (h)) * HTB)
#define MG_SB(b) (LDS_B + (b) * HTB)
#define MG_DMA_A(slot, base) do { _Pragma("unroll") for (int _h = 0; _h < 2; ++_h) _Pragma("unroll") for (int _i = 0; _i < 2; ++_i) \
        __builtin_amdgcn_global_load_lds((const unsigned*)((base) + voffA[_h][_i]), (MG_LAS unsigned*)(lds + MG_SA(slot, _h) + ldsw + _i * 8192), 16, 0, 0); } while (0)
#define MG_LDA(dst, slot, h) do { _Pragma("unroll") for (int m = 0; m < 4; ++m) _Pragma("unroll") for (int k = 0; k < 2; ++k) dst[m][k] = *(const MG_LAS bf16x8*)(lds + MG_SA(slot, h) + (k ? aoff1 : aoff0) + m * 2048); } while (0)
#define MG_LDB(dst, b) do { _Pragma("unroll") for (int n = 0; n < 2; ++n) _Pragma("unroll") for (int k = 0; k < 2; ++k) dst[n][k] = *(const MG_LAS bf16x8*)(lds + MG_SB(b) + (k ? boff1 : boff0) + n * 2048); } while (0)
#define MG_BLOAD(set, p) do { const float* _p = (p); \
        asm volatile("global_load_dwordx4 %0, %1, off" : "=v"(set[0]) : "v"(_p) : "memory"); \
        asm volatile("global_load_dwordx4 %0, %1, off" : "=v"(set[1]) : "v"(_p + (size_t)ldw) : "memory"); \
        asm volatile("global_load_dwordx4 %0, %1, off" : "=v"(set[2]) : "v"(_p + (size_t)2 * ldw) : "memory"); \
        asm volatile("global_load_dwordx4 %0, %1, off" : "=v"(set[3]) : "v"(_p + (size_t)3 * ldw) : "memory"); } while (0)
#define MG_WAIT_B(set) asm volatile("s_waitcnt vmcnt(8)" : "+v"(set[0]), "+v"(set[1]), "+v"(set[2]), "+v"(set[3]) :: "memory")
#define MG_BWRITE(set, b) do { _Pragma("unroll") for (int _i = 0; _i < 4; ++_i) { u32x2 _w; _w.x = cvt_pk_bf16(set[0][_i], set[1][_i]); _w.y = cvt_pk_bf16(set[2][_i], set[3][_i]); \
        *(MG_LAS u32x2*)(lds + MG_SB(b) + bwr[_i]) = _w; } } while (0)
#define MG_MMA(ai, At) do { _Pragma("unroll") for (int m = 0; m < 4; ++m) _Pragma("unroll") for (int n = 0; n < 2; ++n) _Pragma("unroll") for (int k = 0; k < 2; ++k) \
        acc[ai][m][n] = __builtin_amdgcn_mfma_f32_16x16x32_bf16(Bf[n][k], At[m][k], acc[ai][m][n], 0, 0, 0); } while (0)
#define MG_WAIT_V(n) asm volatile("s_waitcnt vmcnt(" #n ")" ::: "memory")
#define MG_WAIT_L(n) asm volatile("s_waitcnt lgkmcnt(" #n ")" ::: "memory")
#define MG_BAR __builtin_amdgcn_s_barrier()
#define MG_SCHED __builtin_amdgcn_sched_barrier(0)
#define MG_GATH(gp) do { if constexpr (GATHER) { _Pragma("unroll") for (int _i = 0; _i < 2; ++_i) { const int R_ = 8 * wid + 64 * _i + (lane >> 3), C_ = 8 * ((lane ^ (lane >> 3)) & 7); \
        voffA[0][_i] = (unsigned)((gp)[R_] * lda + C_) * 2u; voffA[1][_i] = (unsigned)((gp)[R_ + 128] * lda + C_) * 2u; } } } while (0)
    Unit cu, au, bu; int ia = 0, ib = 0, ic = 0;
    if (!S.next(0, cu)) return;
    au = cu; bu = cu;
    const char* pa = au.A; int ta = 0; bool aend = false;
    const float* pb = BMap::src(bu, 4 * ng) + (size_t)brow * ldw; int tb = 0; bool bend = false;
    MG_GATH(au.gath);
#define MG_ADV_A() do { ++ta; pa += kstepA; if (ta == nt) { Unit nu_; if (!aend && S.next(ia + 1, nu_)) { ++ia; au = nu_; pa = au.A; ta = 0; MG_GATH(au.gath); } else { aend = true; ta = nt - 1; pa -= kstepA; } } } while (0)
#define MG_ADV_B() do { ++tb; pb += kstepB; if (tb == nt) { Unit nu_; if (!bend && S.next(ib + 1, nu_)) { ++ib; bu = nu_; pb = BMap::src(bu, 4 * ng) + (size_t)brow * ldw; tb = 0; } else { bend = true; tb = nt - 1; pb -= kstepB; } } } while (0)
    f32x4 acc[2][4][2];
#pragma unroll
    for (int a = 0; a < 2; ++a)
#pragma unroll
        for (int m = 0; m < 4; ++m)
#pragma unroll
            for (int n = 0; n < 2; ++n) acc[a][m][n] = (f32x4){0.f, 0.f, 0.f, 0.f};
    bf16x8 At0[4][2], At1[4][2], Bf[2][2];
    f32x4 Bx[4], By[4];
    MG_BLOAD(Bx, pb); MG_ADV_B();
    MG_DMA_A(0, pa); MG_ADV_A();
    MG_BLOAD(By, pb); MG_ADV_B();
    MG_DMA_A(1, pa); MG_ADV_A();
    MG_WAIT_B(Bx);
    MG_BWRITE(Bx, 0);
    MG_BLOAD(Bx, pb); MG_ADV_B();
    MG_WAIT_L(0); MG_BAR;
    if (wr == 1) MG_BAR;
    int slot = 0;
#define MG_STEP(Bnext, bcur, bnext) do { \
        const int s2_ = (slot == 0) ? 2 : slot - 1;                        \
        MG_LDB(Bf, bcur); MG_SCHED; MG_LDA(At0, slot, 0); MG_LDA(At1, slot, 1); \
        MG_DMA_A(s2_, pa); MG_ADV_A(); \
        MG_WAIT_B(Bnext); \
        MG_BWRITE(Bnext, bnext); \
        MG_BLOAD(Bnext, pb); MG_ADV_B(); \
        MG_WAIT_L(0); MG_BAR; \
        __builtin_amdgcn_s_setprio(1); MG_MMA(0, At0); if (cu.nv > 128) { MG_MMA(1, At1); } __builtin_amdgcn_s_setprio(0); \
        MG_BAR; MG_SCHED; \
        slot = (slot == 2) ? 0 : slot + 1; } while (0)
    for (;;) {
#pragma unroll 1
        for (int t = 0; t < nt; t += 2) { MG_STEP(By, 0, 1); MG_STEP(Bx, 1, 0); }
        E(acc, cu, wr, wc, fr, fq);
        Unit nu;
        if (!S.next(ic + 1, nu)) break;
        ++ic; cu = nu;
#pragma unroll
        for (int a = 0; a < 2; ++a)
#pragma unroll
            for (int m = 0; m < 4; ++m)
#pragma unroll
                for (int n = 0; n < 2; ++n) acc[a][m][n] = (f32x4){0.f, 0.f, 0.f, 0.f};
    }
    MG_WAIT_V(0);
    if (wr == 0) MG_BAR;
    MG_BAR;
#undef MG_SA
#undef MG_SB
#undef MG_DMA_A
#undef MG_LDA
#undef MG_LDB
#undef MG_BLOAD
#undef MG_WAIT_B
#undef MG_BWRITE
#undef MG_MMA
#undef MG_WAIT_V
#undef MG_WAIT_L
#undef MG_BAR
#undef MG_SCHED
#undef MG_GATH
#undef MG_ADV_A
#undef MG_ADV_B
#undef MG_STEP
}
template <class Epi, class Sched, class BMap, bool GATHER>
__device__ __forceinline__ void gemm_phase8(MG_LAS unsigned char* lds, const int K, const int lda, const int ldw, const Sched& S, const Epi& E) {
    int tid_ = threadIdx.x; asm volatile("" : "+v"(tid_));
    const int tid = tid_, wid = __builtin_amdgcn_readfirstlane(tid >> 6), lane = tid & 63, wr = wid >> 2, wc = wid & 3, fr = lane & 15, fq = lane >> 4;
    const int nt = K / 128;
    unsigned voffA[2][2];
#pragma unroll
    for (int i = 0; i < 2; ++i) { const int R = 8 * wid + 64 * i + (lane >> 3), C = 8 * ((lane ^ (lane >> 3)) & 7); voffA[0][i] = (unsigned)(R * lda + C) * 2u; voffA[1][i] = (unsigned)((R + 128) * lda + C) * 2u; }
    const unsigned ldsw = (unsigned)wid * 1024u;
    const int aoff0 = lds_x(wr * 64 + fr, fq * 8), aoff1 = aoff0 ^ 64, boff0 = lds_x(wc * 32 + fr, fq * 8), boff1 = boff0 ^ 64;
    const int kh = lane & 1, kc = ((lane >> 1) & 3) | ((wid & 1) << 2), ng = ((lane >> 3) & 7) | ((wid >> 1) << 3);
    const int brow = 16 * kc + 8 * kh;
    unsigned bwr[4];
#pragma unroll
    for (int i = 0; i < 4; ++i) bwr[i] = (unsigned)lds_x(4 * ng + i, 8 * kc + 4 * kh);
    const size_t kstepA = 128, kstepB = (size_t)128 * ldw;
#define MG_SA(s, h) (LDS_A + ((s) * 2 + (h)) * HTB)
#define MG_SB(b) (LDS_B + (b) * HTB)
#define MG_DMA_A(slot, base) do { _Pragma("unroll") for (int _h = 0; _h < 2; ++_h) _Pragma("unroll") for (int _i = 0; _i < 2; ++_i) \
        __builtin_amdgcn_global_load_lds((const unsigned*)((base) + voffA[_h][_i]), (MG_LAS unsigned*)(lds + MG_SA(slot, _h) + ldsw + _i * 8192), 16, 0, 0); } while (0)
#define MG_LDA(dst, slot, h) do { _Pragma("unroll") for (int m = 0; m < 4; ++m) _Pragma("unroll") for (int k = 0; k < 2; ++k) dst[m][k] = *(const MG_LAS bf16x8*)(lds + MG_SA(slot, h) + (k ? aoff1 : aoff0) + m * 2048); } while (0)
#define MG_LDB(dst, b) do { _Pragma("unroll") for (int n = 0; n < 2; ++n) _Pragma("unroll") for (int k = 0; k < 2; ++k) dst[n][k] = *(const MG_LAS bf16x8*)(lds + MG_SB(b) + (k ? boff1 : boff0) + n * 2048); } while (0)
#define MG_BLOAD(set, p) do { const float* _p = (p); _Pragma("unroll") for (int _j = 0; _j < 8; ++_j) \
        asm volatile("global_load_dwordx4 %0, %1, off" : "=v"(set[_j]) : "v"(_p + (size_t)_j * ldw) : "memory"); } while (0)
#define MG_WAIT_B(set) asm volatile("s_waitcnt vmcnt(4)" : "+v"(set[0]), "+v"(set[1]), "+v"(set[2]), "+v"(set[3]), "+v"(set[4]), "+v"(set[5]), "+v"(set[6]), "+v"(set[7]) :: "memory")
#define MG_BWRITE(set, b) do { _Pragma("unroll") for (int _i = 0; _i < 4; ++_i) { u32x2 _w; \
        int _a = __builtin_amdgcn_cvt_pk_fp8_f32(set[0][_i] * 64.f, set[1][_i] * 64.f, 0, false); _a = __builtin_amdgcn_cvt_pk_fp8_f32(set[2][_i] * 64.f, set[3][_i] * 64.f, _a, true); \
        int _b = __builtin_amdgcn_cvt_pk_fp8_f32(set[4][_i] * 64.f, set[5][_i] * 64.f, 0, false); _b = __builtin_amdgcn_cvt_pk_fp8_f32(set[6][_i] * 64.f, set[7][_i] * 64.f, _b, true); \
        _w.x = (unsigned)_a; _w.y = (unsigned)_b; *(MG_LAS u32x2*)(lds + MG_SB(b) + bwr[_i]) = _w; } } while (0)
#define MG_MMA(ai, At) do { typedef long l2_ __attribute__((ext_vector_type(2))); _Pragma("unroll") for (int m = 0; m < 4; ++m) _Pragma("unroll") for (int n = 0; n < 2; ++n) _Pragma("unroll") for (int k = 0; k < 2; ++k) { \
        const l2_ b_ = __builtin_bit_cast(l2_, Bf[n][k]), a_ = __builtin_bit_cast(l2_, At[m][k]); \
        acc[ai][m][n] = __builtin_amdgcn_mfma_f32_16x16x32_fp8_fp8(b_.x, a_.x, acc[ai][m][n], 0, 0, 0); acc[ai][m][n] = __builtin_amdgcn_mfma_f32_16x16x32_fp8_fp8(b_.y, a_.y, acc[ai][m][n], 0, 0, 0); } } while (0)
#define MG_WAIT_V(n) asm volatile("s_waitcnt vmcnt(" #n ")" ::: "memory")
#define MG_WAIT_L(n) asm volatile("s_waitcnt lgkmcnt(" #n ")" ::: "memory")
#define MG_BAR __builtin_amdgcn_s_barrier()
#define MG_SCHED __builtin_amdgcn_sched_barrier(0)
#define MG_GATH(gp) do { if constexpr (GATHER) { _Pragma("unroll") for (int _i = 0; _i < 2; ++_i) { const int R_ = 8 * wid + 64 * _i + (lane >> 3), C_ = 8 * ((lane ^ (lane >> 3)) & 7); \
        voffA[0][_i] = (unsigned)((gp)[R_] * lda + C_) * 2u; voffA[1][_i] = (unsigned)((gp)[R_ + 128] * lda + C_) * 2u; } } } while (0)
    Unit cu, au, bu; int ia = 0, ib = 0, ic = 0;
    if (!S.next(0, cu)) return;
    au = cu; bu = cu;
    const char* pa = au.A; int ta = 0; bool aend = false;
    const float* pb = BMap::src(bu, 4 * ng) + (size_t)brow * ldw; int tb = 0; bool bend = false;
    MG_GATH(au.gath);
#define MG_ADV_A() do { ++ta; pa += kstepA; if (ta == nt) { Unit nu_; if (!aend && S.next(ia + 1, nu_)) { ++ia; au = nu_; pa = au.A; ta = 0; MG_GATH(au.gath); } else { aend = true; ta = nt - 1; pa -= kstepA; } } } while (0)
#define MG_ADV_B() do { ++tb; pb += kstepB; if (tb == nt) { Unit nu_; if (!bend && S.next(ib + 1, nu_)) { ++ib; bu = nu_; pb = BMap::src(bu, 4 * ng) + (size_t)brow * ldw; tb = 0; } else { bend = true; tb = nt - 1; pb -= kstepB; } } } while (0)
    f32x4 acc[2][4][2];
#pragma unroll
    for (int a = 0; a < 2; ++a)
#pragma unroll
        for (int m = 0; m < 4; ++m)
#pragma unroll
            for (int n = 0; n < 2; ++n) acc[a][m][n] = (f32x4){0.f, 0.f, 0.f, 0.f};
    bf16x8 At0[4][2], At1[4][2], Bf[2][2];
    f32x4 Bx[8];
    MG_BLOAD(Bx, pb); MG_ADV_B();
    MG_DMA_A(0, pa); MG_ADV_A();
    MG_DMA_A(1, pa); MG_ADV_A();
    MG_WAIT_B(Bx);
    MG_BWRITE(Bx, 0);
    MG_BLOAD(Bx, pb); MG_ADV_B();
    MG_WAIT_L(0); MG_BAR;
    if (wr == 1) MG_BAR;
    int slot = 0;
#define MG_STEP(bcur, bnext) do { \
        const int s2_ = (slot == 0) ? 2 : slot - 1;                        \
        MG_LDB(Bf, bcur); MG_SCHED; MG_LDA(At0, slot, 0); MG_LDA(At1, slot, 1); \
        MG_DMA_A(s2_, pa); MG_ADV_A(); \
        MG_WAIT_B(Bx); \
        MG_BWRITE(Bx, bnext); \
        MG_BLOAD(Bx, pb); MG_ADV_B(); \
        MG_WAIT_L(0); MG_BAR; \
        __builtin_amdgcn_s_setprio(1); MG_MMA(0, At0); if (cu.nv > 128) { MG_MMA(1, At1); } __builtin_amdgcn_s_setprio(0); \
        MG_BAR; MG_SCHED; \
        slot = (slot == 2) ? 0 : slot + 1; } while (0)
    for (;;) {
#pragma unroll 1
        for (int t = 0; t < nt; t += 2) { MG_STEP(0, 1); MG_STEP(1, 0); }
        E(acc, cu, wr, wc, fr, fq);
        Unit nu;
        if (!S.next(ic + 1, nu)) break;
        ++ic; cu = nu;
#pragma unroll
        for (int a = 0; a < 2; ++a)
#pragma unroll
            for (int m = 0; m < 4; ++m)
#pragma unroll
                for (int n = 0; n < 2; ++n) acc[a][m][n] = (f32x4){0.f, 0.f, 0.f, 0.f};
    }
    MG_WAIT_V(0);
    if (wr == 0) MG_BAR;
    MG_BAR;
#undef MG_SA
#undef MG_SB
#undef MG_DMA_A
#undef MG_LDA
#undef MG_LDB
#undef MG_BLOAD
#undef MG_WAIT_B
#undef MG_BWRITE
#undef MG_MMA
#undef MG_WAIT_V
#undef MG_WAIT_L
#undef MG_BAR
#undef MG_SCHED
#undef MG_GATH
#undef MG_ADV_A
#undef MG_ADV_B
#undef MG_STEP
}
}
namespace attn_body {
using bf16=__hip_bfloat16;
using bf16x8=__attribute__((ext_vector_type(8)))short;
using s16x4=__attribute__((ext_vector_type(4)))short;
using f32x16=__attribute__((ext_vector_type(16)))float;
using u32x4=__attribute__((ext_vector_type(4)))unsigned;
constexpr int BATCH=2,NHEAD=8,SEQ=8192,D=64,PQ=1536,PO=1024;
constexpr int NW=8,QBLK=32,QB=QBLK*NW,KVBLK=64,NQB=SEQ/QB;
constexpr int ATTN_UNIT_ROWS=QB;
__device__ __forceinline__ int crow(int r,int hi){return (r&3)+8*(r>>2)+4*hi;}
#define SBAR() __builtin_amdgcn_sched_barrier(0)
__device__ __forceinline__ void cmask(f32x16&p0,f32x16&p1,int jb,int qrel,int hi){
  const float NEG=-INFINITY; int kb=64*jb+4*hi;
  #pragma unroll
  for(int r=0;r<16;++r){int kv=kb+(r&3)+8*(r>>2); if(kv>qrel)p0[r]=NEG; if(kv+32>qrel)p1[r]=NEG;}
}

constexpr int NSLOT=3, SLOTB=8192;
constexpr int LDS_K=0, LDS_V=NSLOT*SLOTB, LDS_WS=3*NSLOT*SLOTB, LDS_OST=LDS_WS+NW*64*4, LDS_BYTES=LDS_OST+NW*4096;
constexpr float C2=0.125f*1.4426950408889634f;
__device__ __forceinline__ void glds16(const void*gsrc,unsigned lds_dst){unsigned keep;
  asm volatile("s_mov_b32 %0, m0\n\ts_mov_b32 m0, %2\n\ts_nop 0\n\tglobal_load_lds_dwordx4 %1, off\n\ts_mov_b32 m0, %0":"=&s"(keep):"v"(gsrc),"s"(lds_dst):"memory");}
__device__ __forceinline__ float max3f(float a,float b,float c){float r;asm("v_max3_f32 %0, %1, %2, %3":"=v"(r):"v"(a),"v"(b),"v"(c));return r;}
__device__ __forceinline__ float max2f(float a,float b){float r;asm("v_max_f32_e32 %0, %1, %2":"=v"(r):"v"(a),"v"(b));return r;}
__device__ __forceinline__ float fadd_s(float a,float b){float r;asm("v_add_f32_e32 %0, %1, %2":"=v"(r):"v"(a),"v"(b));return r;}
__device__ __forceinline__ float fsub_s(float a,float b){float r;asm("v_sub_f32_e32 %0, %1, %2":"=v"(r):"v"(a),"v"(b));return r;}
typedef float f32x2_t __attribute__((ext_vector_type(2))); typedef __bf16 bf16x2_t __attribute__((ext_vector_type(2)));
__device__ __forceinline__ unsigned cvtpk_s(float lo,float hi){f32x2_t v={lo,hi};bf16x2_t b=__builtin_convertvector(v,bf16x2_t);return __builtin_bit_cast(unsigned,b);}
#define WAIT_BAR(N) asm volatile("s_waitcnt vmcnt(" #N ") lgkmcnt(0)\n\ts_barrier":::"memory")

__device__ __forceinline__ void qkt(f32x16&p0,f32x16&p1,const char*Kslot,const bf16x8*qr,int r32,int hi){ const f32x16 negm=f32x16{};
  const char*kb=Kslot+hi*1024+r32*16;
  #pragma unroll
  for(int d0=0;d0<4;++d0){
    const bf16x8 b0=*reinterpret_cast<const bf16x8*>(kb+d0*2048);
    const bf16x8 b1=*reinterpret_cast<const bf16x8*>(kb+d0*2048+512);
    if(d0==0){p0=__builtin_amdgcn_mfma_f32_32x32x16_bf16(b0,qr[0],negm,0,0,0);p1=__builtin_amdgcn_mfma_f32_32x32x16_bf16(b1,qr[0],negm,0,0,0);}
    else{p0=__builtin_amdgcn_mfma_f32_32x32x16_bf16(b0,qr[d0],p0,0,0,0);p1=__builtin_amdgcn_mfma_f32_32x32x16_bf16(b1,qr[d0],p1,0,0,0);}}
}
typedef __attribute__((address_space(3))) const char* lds_cptr;
typedef short v4i16_t __attribute__((ext_vector_type(4)));
__device__ __forceinline__ void kload8(bf16x8*kf,lds_cptr kp){
  kf[0]=*(const __attribute__((address_space(3))) bf16x8*)(kp);      kf[1]=*(const __attribute__((address_space(3))) bf16x8*)(kp+512);
  kf[2]=*(const __attribute__((address_space(3))) bf16x8*)(kp+2048); kf[3]=*(const __attribute__((address_space(3))) bf16x8*)(kp+2560);
  kf[4]=*(const __attribute__((address_space(3))) bf16x8*)(kp+4096); kf[5]=*(const __attribute__((address_space(3))) bf16x8*)(kp+4608);
  kf[6]=*(const __attribute__((address_space(3))) bf16x8*)(kp+6144); kf[7]=*(const __attribute__((address_space(3))) bf16x8*)(kp+6656);
}
__device__ __forceinline__ void kload2(bf16x8*kf,lds_cptr kp,int j){ kf[2*j]=*(const __attribute__((address_space(3))) bf16x8*)(kp+j*2048); kf[2*j+1]=*(const __attribute__((address_space(3))) bf16x8*)(kp+j*2048+512); }
__device__ __forceinline__ s16x4 vtr(lds_cptr p){ return __builtin_bit_cast(s16x4,__builtin_amdgcn_ds_read_tr16_b64_v4i16((__attribute__((address_space(3))) v4i16_t*)p)); }
__device__ __forceinline__ float rowmax(const f32x16&p0,const f32x16&p1){
  float a=max3f(p0[0],p0[1],p1[0]),b=max3f(p0[2],p0[3],p1[1]);a=max3f(a,p1[2],p1[3]);
  #pragma unroll
  for(int r=4;r<16;r+=4){a=max3f(a,p0[r],p0[r+1]);b=max3f(b,p0[r+2],p0[r+3]);a=max3f(a,p1[r],p1[r+1]);b=max3f(b,p1[r+2],p1[r+3]);}
  const float m=max2f(a,b);
  auto rr=__builtin_amdgcn_permlane32_swap(__float_as_uint(m),__float_as_uint(m),false,false);
  return max2f(__uint_as_float(rr[0]),__uint_as_float(rr[1]));
}
__device__ __forceinline__ void pv(f32x16*o,int vb,bf16x8 pa0,bf16x8 pa1,bf16x8 pa2,bf16x8 pa3){
  #pragma unroll
  for(int d0=0;d0<4;++d0){s16x4 lo[4],hi[4];
    #pragma unroll
    for(int ks=0;ks<4;++ks){
      asm volatile("ds_read_b64_tr_b16 %0,%1 offset:%c2":"=&v"(lo[ks]):"v"(vb),"i"(d0*4096+ks*1024):"memory");
      asm volatile("ds_read_b64_tr_b16 %0,%1 offset:%c2":"=&v"(hi[ks]):"v"(vb),"i"(d0*4096+ks*1024+512):"memory");}
    asm volatile("s_waitcnt lgkmcnt(0)":::"memory");SBAR();
    #define PK(k) (bf16x8){lo[k][0],lo[k][1],lo[k][2],lo[k][3],hi[k][0],hi[k][1],hi[k][2],hi[k][3]}
    o[d0]=__builtin_amdgcn_mfma_f32_32x32x16_bf16(pa0,PK(0),o[d0],0,0,0);
    o[d0]=__builtin_amdgcn_mfma_f32_32x32x16_bf16(pa1,PK(1),o[d0],0,0,0);
    o[d0]=__builtin_amdgcn_mfma_f32_32x32x16_bf16(pa2,PK(2),o[d0],0,0,0);
    o[d0]=__builtin_amdgcn_mfma_f32_32x32x16_bf16(pa3,PK(3),o[d0],0,0,0);
    #undef PK
  }
}

#ifndef ATTN_STORE16
#define ATTN_STORE16(p,v) (*(u32x4*)(p)=(v))
#endif
template<int THRL> __device__ __forceinline__ void attn_unit(int b,int qcol,int kcol,int vcol,int ocol,int qb,const bf16*__restrict__ QKV,bf16*O,char*shm){
  int tid_=threadIdx.x; asm volatile("":"+v"(tid_)); const int tid=tid_,lane=tid&63,r32=lane&31,hi=lane>>5; const int wid=__builtin_amdgcn_readfirstlane(tid>>6);
  const long rowbase=(long)b*SEQ; const int q0=qb*QB;
  const bf16*Qw=QKV+(rowbase+q0+wid*QBLK)*PQ+qcol;
  const bf16*Kh=QKV+rowbase*PQ+kcol,*Vh=QKV+rowbase*PQ+vcol;
  const unsigned lds0=(unsigned)(uintptr_t)shm;
  float*wsf=(float*)(shm+LDS_WS)+wid*64;
  const bf16*ksrc=Kh+(long)lane*PQ+wid*8;
  const bf16*vsrc=Vh+(long)(16*(wid&3)+(lane>>2))*PQ+(wid>>2)*32+(lane&3)*8;
  const unsigned kdst=lds0+LDS_K+wid*1024, vdst=lds0+LDS_V+wid*1024;
  #define DMA_K(t,slot) glds16(ksrc+(long)(t)*KVBLK*PQ,(unsigned)__builtin_amdgcn_readfirstlane(kdst+(slot)))
  #define DMA_V(t,slot) do{ glds16(vsrc+(long)(t)*KVBLK*PQ,(unsigned)__builtin_amdgcn_readfirstlane(vdst+2*(slot))); glds16(vsrc+64+(long)(t)*KVBLK*PQ,(unsigned)__builtin_amdgcn_readfirstlane(vdst+2*(slot)+8192)); }while(0)
  const int vb0=(int)(lds0+LDS_V)+((lane>>4)&1)*32+(lane&3)*8+(4*hi+((lane&15)>>2))*64;
  const char*Kbase=shm+LDS_K; bf16x8 kf[8];
  const lds_cptr shm3=(lds_cptr)shm; const lds_cptr kp0=shm3+LDS_K+hi*1024+r32*16; const lds_cptr vp0=shm3+LDS_V+((lane>>4)&1)*32+(lane&3)*8+(4*hi+((lane&15)>>2))*64;
  const int NT=(q0+QB)/KVBLK;
  DMA_K(0,0);DMA_V(0,0);DMA_K(1,SLOTB);
  bf16x8 qr[4];
  #pragma unroll
  for(int d0=0;d0<4;++d0)qr[d0]=*reinterpret_cast<const bf16x8*>(&Qw[(long)r32*PQ+d0*16+hi*8]);
  float mhat=0.f,l_reg=0.f;f32x16 o[4];o[0]=f32x16{};o[1]=f32x16{};o[2]=f32x16{};o[3]=f32x16{};
  const int qrel=wid*QBLK+r32;
  #define CMASK(P0,P1,t) do{int jb_=(t)-(NT-4); if(jb_>=0)cmask(P0,P1,jb_,qrel,hi);}while(0)
  bool resc=false;
  #define START(P0,P1) do{ const float rm=rowmax(P0,P1); resc=false; mhat=rm; \
    _Pragma("unroll") for(int r=0;r<16;++r)P0[r]=__builtin_amdgcn_exp2f(fsub_s(P0[r],mhat)); }while(0)
  #define RESC() do{ if(resc){ asm volatile("s_waitcnt lgkmcnt(0)":::"memory"); \
      _Pragma("unroll") for(int d_=0;d_<4;++d_) _Pragma("unroll") for(int r=0;r<16;++r)o[d_][r]*=wsf[crow(r,hi)]; } }while(0)
  f32x16 pA0,pA1,pB0,pB1;
  int sl_prev=0,sl_cur=0,sl_next=SLOTB;
  #define ROT() do{sl_prev=sl_cur;sl_cur=sl_next;sl_next=(sl_next==(NSLOT-1)*SLOTB)?0:sl_next+SLOTB;}while(0)
  DMA_K(2,2*SLOTB);
  WAIT_BAR(4);
  qkt(pA0,pA1,Kbase,qr,r32,hi);asm volatile("s_nop 15\n\ts_nop 7":"+v"(pA0),"+v"(pA1));CMASK(pA0,pA1,0);
  START(pA0,pA1);
  _Pragma("unroll") for(int r=0;r<16;++r)pA1[r]=__builtin_amdgcn_exp2f(pA1[r]-mhat);
  WAIT_BAR(0);
  DMA_K(3,0);DMA_V(1,SLOTB);
  ROT();
  kload8(kf,kp0+sl_cur);
  WAIT_BAR(3);
  s16x4 vlo[8],vhi[8]; u32x4 pw0,pw1,pw2,pw3;
  #define PKW(P,B) cvtpk_s(P[B],P[B+1])
  #define PAF(k) __builtin_bit_cast(bf16x8,pw##k)
  #define VFR(i) (bf16x8){vlo[i][0],vlo[i][1],vlo[i][2],vlo[i][3],vhi[i][0],vhi[i][1],vhi[i][2],vhi[i][3]}
  #define PIN(x) asm volatile("":"+v"(x))
  #define MX3(a,b,c) __builtin_fmaxf(__builtin_fmaxf((a),(b)),(c))
  #define GAPA(MF,A0,A1,A2,A3,W0,W1,PW) do{ MF; sacc+=A0; sacc+=A1; sacc+=A2; sacc+=A3; PIN(sacc); W0; W1; PIN(PW); SBAR(); }while(0)
  #define EX(v) __builtin_amdgcn_exp2f(v)
  #define GAPB(MF,X,B,RD) do{ MF; X[B]=EX(X[B]-mhat); X[B+1]=EX(X[B+1]-mhat); PIN(X); RD; SBAR(); }while(0)
  #define VRD(i) do{ vlo[i]=vtr(vp_+(((i)>>2)*4096+((i)&3)*1024)); vhi[i]=vtr(vp_+(((i)>>2)*4096+((i)&3)*1024+512)); }while(0)
  #define VRD2(i) do{ vlo[i]=vtr(vp_+((((i)>>2)+2)*4096+((i)&3)*1024)); vhi[i]=vtr(vp_+((((i)>>2)+2)*4096+((i)&3)*1024+512)); }while(0)
  #define NORD do{}while(0)
  #define KRD(G,j) do{ if(G){ kload2(kf,kp0+sl_next,j); SBAR(); } }while(0)
  #define STEP(C0,C1,P0,P1,t,GK,GV,GL) do{ SBAR(); \
    const lds_cptr vp_=vp0+2*sl_prev; \
    VRD(0); SBAR(); float sacc=(P0[0]+P0[1]); \
    GAPA(C0=__builtin_amdgcn_mfma_f32_32x32x16_bf16(kf[0],qr[0],f32x16{},0,0,0), P0[2],P0[3],P0[4],P0[5],     pw0[0]=PKW(P0,0), pw0[1]=PKW(P0,2), pw0); \
    VRD(4); SBAR(); GAPA(C1=__builtin_amdgcn_mfma_f32_32x32x16_bf16(kf[1],qr[0],f32x16{},0,0,0), P0[6],P0[7],P0[8],P0[9],     pw0[2]=PKW(P0,4), pw0[3]=PKW(P0,6), pw0); \
    VRD(1); SBAR(); GAPA(C0=__builtin_amdgcn_mfma_f32_32x32x16_bf16(kf[2],qr[1],C0,0,0,0),   P0[10],P0[11],P0[12],P0[13], pw1[0]=PKW(P0,8), pw1[1]=PKW(P0,10), pw1); \
    VRD(5); SBAR(); GAPA(C1=__builtin_amdgcn_mfma_f32_32x32x16_bf16(kf[3],qr[1],C1,0,0,0),   P0[14],P0[15],P1[0],P1[1],   pw1[2]=PKW(P0,12),pw1[3]=PKW(P0,14), pw1); \
    VRD(2); SBAR(); GAPA(C0=__builtin_amdgcn_mfma_f32_32x32x16_bf16(kf[4],qr[2],C0,0,0,0),   P1[2],P1[3],P1[4],P1[5],     pw2[0]=PKW(P1,0), pw2[1]=PKW(P1,2), pw2); \
    VRD(6); SBAR(); GAPA(C1=__builtin_amdgcn_mfma_f32_32x32x16_bf16(kf[5],qr[2],C1,0,0,0),   P1[6],P1[7],P1[8],P1[9],     pw2[2]=PKW(P1,4), pw2[3]=PKW(P1,6), pw2); \
    VRD(3); SBAR(); GAPA(C0=__builtin_amdgcn_mfma_f32_32x32x16_bf16(kf[6],qr[3],C0,0,0,0),   P1[10],P1[11],P1[12],P1[13], pw3[0]=PKW(P1,8), pw3[1]=PKW(P1,10), pw3); \
    VRD(7); SBAR(); GAPA(C1=__builtin_amdgcn_mfma_f32_32x32x16_bf16(kf[7],qr[3],C1,0,0,0),   P1[14],P1[15],0.f,0.f,       pw3[2]=PKW(P1,12),pw3[3]=PKW(P1,14), pw3); \
    l_reg+=sacc; \
    if(GK){DMA_K((t)+3,sl_cur);} if(GV){DMA_V((t)+1,sl_next);} \
    CMASK(C0,C1,t); \
    { float a=MX3(C0[0],C0[1],C1[0]),b=MX3(C0[2],C0[3],C1[1]); a=MX3(a,C1[2],C1[3]); \
      _Pragma("unroll") for(int r=4;r<16;r+=4){a=MX3(a,C0[r],C0[r+1]);b=MX3(b,C0[r+2],C0[r+3]);a=MX3(a,C1[r],C1[r+1]);b=MX3(b,C1[r+2],C1[r+3]);} \
      float rm=__builtin_fmaxf(a,b); { auto rr=__builtin_amdgcn_permlane32_swap(__float_as_uint(rm),__float_as_uint(rm),false,false); rm=__builtin_fmaxf(__uint_as_float(rr[0]),__uint_as_float(rr[1])); } \
      rm-=mhat; resc=false; \
      if(__builtin_expect(__any(rm>(float)THRL),0)){ const float dl=__builtin_fmaxf(rm,0.f); mhat+=dl; \
        const float f=__builtin_amdgcn_exp2f(-dl); l_reg*=f; if(hi==0)wsf[r32]=f; resc=true; } } \
    SBAR(); \
    GAPB(o[0]=__builtin_amdgcn_mfma_f32_32x32x16_bf16(PAF(0),VFR(0),o[0],0,0,0), C0,0, VRD2(0)); \
    GAPB(o[1]=__builtin_amdgcn_mfma_f32_32x32x16_bf16(PAF(0),VFR(4),o[1],0,0,0), C0,2, VRD2(4)); \
    KRD(GL,0); GAPB(o[0]=__builtin_amdgcn_mfma_f32_32x32x16_bf16(PAF(1),VFR(1),o[0],0,0,0), C0,4, VRD2(1)); \
    KRD(GL,1); GAPB(o[1]=__builtin_amdgcn_mfma_f32_32x32x16_bf16(PAF(1),VFR(5),o[1],0,0,0), C0,6, VRD2(5)); \
    KRD(GL,2); GAPB(o[0]=__builtin_amdgcn_mfma_f32_32x32x16_bf16(PAF(2),VFR(2),o[0],0,0,0), C0,8, VRD2(2)); \
    KRD(GL,3); GAPB(o[1]=__builtin_amdgcn_mfma_f32_32x32x16_bf16(PAF(2),VFR(6),o[1],0,0,0), C0,10, VRD2(6)); \
    GAPB(o[0]=__builtin_amdgcn_mfma_f32_32x32x16_bf16(PAF(3),VFR(3),o[0],0,0,0), C0,12, VRD2(3)); \
    GAPB(o[1]=__builtin_amdgcn_mfma_f32_32x32x16_bf16(PAF(3),VFR(7),o[1],0,0,0), C0,14, VRD2(7)); \
    GAPB(o[2]=__builtin_amdgcn_mfma_f32_32x32x16_bf16(PAF(0),VFR(0),o[2],0,0,0), C1,0, NORD); \
    GAPB(o[3]=__builtin_amdgcn_mfma_f32_32x32x16_bf16(PAF(0),VFR(4),o[3],0,0,0), C1,2, NORD); \
    GAPB(o[2]=__builtin_amdgcn_mfma_f32_32x32x16_bf16(PAF(1),VFR(1),o[2],0,0,0), C1,4, NORD); \
    GAPB(o[3]=__builtin_amdgcn_mfma_f32_32x32x16_bf16(PAF(1),VFR(5),o[3],0,0,0), C1,6, NORD); \
    GAPB(o[2]=__builtin_amdgcn_mfma_f32_32x32x16_bf16(PAF(2),VFR(2),o[2],0,0,0), C1,8, NORD); \
    GAPB(o[3]=__builtin_amdgcn_mfma_f32_32x32x16_bf16(PAF(2),VFR(6),o[3],0,0,0), C1,10, NORD); \
    GAPB(o[2]=__builtin_amdgcn_mfma_f32_32x32x16_bf16(PAF(3),VFR(3),o[2],0,0,0), C1,12, NORD); \
    GAPB(o[3]=__builtin_amdgcn_mfma_f32_32x32x16_bf16(PAF(3),VFR(7),o[3],0,0,0), C1,14, NORD); \
    }while(0)
  int t=1;
  #undef CMASK
  #define CMASK(P0,P1,t) do{}while(0)
  for(;t+5<NT;t+=2){
    STEP(pB0,pB1,pA0,pA1,t,true,true,true);     WAIT_BAR(3); RESC(); ROT();
    STEP(pA0,pA1,pB0,pB1,t+1,true,true,true);   WAIT_BAR(3); RESC(); ROT();
  }
  #undef CMASK
  #define CMASK(P0,P1,t) do{int jb_=(t)-(NT-4); if(jb_>=0)cmask(P0,P1,jb_,qrel,hi);}while(0)
  #define ENDW(tt) do{ if((tt)+3<NT){WAIT_BAR(3);} else if((tt)+2<NT){WAIT_BAR(2);} else {WAIT_BAR(0);} }while(0)
  for(;t+1<NT;t+=2){
    STEP(pB0,pB1,pA0,pA1,t,(t+3<NT),(t+1<NT),(t+1<NT));       ENDW(t);   RESC(); ROT();
    STEP(pA0,pA1,pB0,pB1,t+1,(t+4<NT),(t+2<NT),(t+2<NT));     ENDW(t+1); RESC(); ROT();
  }
  STEP(pB0,pB1,pA0,pA1,NT-1,false,false,false); RESC();
  { float sacc=pB0[0]+pB0[1]; _Pragma("unroll") for(int r=2;r<16;++r)sacc+=pB0[r]; _Pragma("unroll") for(int r=0;r<16;++r)sacc+=pB1[r]; l_reg+=sacc;
    pw0=(u32x4){PKW(pB0,0),PKW(pB0,2),PKW(pB0,4),PKW(pB0,6)};pw1=(u32x4){PKW(pB0,8),PKW(pB0,10),PKW(pB0,12),PKW(pB0,14)};pw2=(u32x4){PKW(pB1,0),PKW(pB1,2),PKW(pB1,4),PKW(pB1,6)};pw3=(u32x4){PKW(pB1,8),PKW(pB1,10),PKW(pB1,12),PKW(pB1,14)};
    SBAR(); pv(o,vb0+2*sl_cur,PAF(0),PAF(1),PAF(2),PAF(3)); }
  #undef PKW
  #undef PAF
  #undef VFR
  #undef PIN
  #undef MX3
  #undef GAPA
  #undef GAPB
  #undef EX
  #undef VRD
  #undef VRD2
  #undef NORD
  #undef KRD
  #undef STEP
  #undef ENDW
  {auto rr=__builtin_amdgcn_permlane32_swap(__float_as_uint(l_reg),__float_as_uint(l_reg),false,false);l_reg=__uint_as_float(rr[0])+__uint_as_float(rr[1]);}
  if(hi==0)wsf[32+r32]=l_reg;asm volatile("s_waitcnt lgkmcnt(0)":::"memory");
  float rli[16];
  #pragma unroll
  for(int r=0;r<16;++r)rli[r]=__builtin_amdgcn_rcpf(wsf[32+crow(r,hi)]);
  bf16*Ow=O+(rowbase+q0+wid*QBLK)*PO+ocol;
  { bf16*stg=(bf16*)(shm+LDS_OST)+wid*2048;
    #pragma unroll
    for(int ps=0;ps<2;++ps){
      #pragma unroll
      for(int r=0;r<16;++r){const int orow=crow(r,hi);
        #pragma unroll
        for(int d0=0;d0<2;++d0)stg[orow*64+d0*32+r32]=__float2bfloat16(o[2*ps+d0][r]*rli[r]);}
      asm volatile("s_waitcnt lgkmcnt(0)":::"memory");
      #pragma unroll
      for(int i=0;i<4;++i){const int row=i*8+(lane>>3),ch=lane&7; const u32x4 v=*(const u32x4*)(stg+row*64+ch*8); ATTN_STORE16(Ow+(long)row*PO+64*ps+ch*8,v);}
      asm volatile("s_waitcnt lgkmcnt(0)":::"memory"); } }
  asm volatile("s_waitcnt lgkmcnt(0)\n\ts_barrier":::"memory");
  #undef DMA_K
  #undef DMA_V
  #undef CMASK
  #undef START
  #undef RESC
  #undef ROT
}
constexpr int ATTN_LDS_BYTES=LDS_BYTES;
struct AttnTensors { const bf16* QKV; bf16* O; };
struct AttnUnit { int bh; int qb; };
struct StaticOrder {
  int vcu;
  __device__ __forceinline__ explicit StaticOrder(int grid,int block):vcu((block%8)*(grid/8)+block/8){}
  __device__ __forceinline__ bool next(int i,AttnUnit&u)const{ if(i>=2)return false; const int s=vcu&15; u.bh=vcu>>4; u.qb=(i==0)?s:31-s; return true; }
  __device__ __forceinline__ void a_ready(const AttnUnit&)const{}
  __device__ __forceinline__ void done(const AttnUnit&)const{}
};
struct QueueOrder {
  __attribute__((address_space(1))) unsigned* head; __attribute__((address_space(3))) int* slot; int xg;
  __device__ __forceinline__ bool next(int,AttnUnit&u)const{
    __syncthreads();
    if(threadIdx.x==0)*slot=(int)__hip_atomic_fetch_add(head,1u,__ATOMIC_RELAXED,__HIP_MEMORY_SCOPE_AGENT);
    __syncthreads();
    const int n=*slot; if(n>=64)return false; u.qb=31-(n>>1); u.bh=2*xg+(n&1); return true; }
  __device__ __forceinline__ void a_ready(const AttnUnit&)const{}
  __device__ __forceinline__ void done(const AttnUnit&)const{}
};
template<class Sched,int THRL=8> __device__ __forceinline__ void attn_phase(char*lds,const AttnTensors&T,const Sched&S){
  AttnUnit u;
  for(int i=0;S.next(i,u);++i){ S.a_ready(u); { const int vh=u.bh%NHEAD, h=vh>>1; attn_unit<THRL>(u.bh/NHEAD,vh*64,512+vh*64,1024+h*128,vh*128,u.qb,T.QKV,T.O,lds); }     S.done(u); }
}
#undef SBAR
#undef WAIT_BAR
}
namespace mk {
constexpr int NWAVES = 8;
constexpr int B_ = 2, L_ = 8192, D_ = 1024, M_ = B_ * L_;
constexpr int NE = 256, NEX = 257, TOPK = 8, NSLOT = M_ * TOPK, NSLOT_ALL = NSLOT + M_;
constexpr float NORM_EPS = 1e-6f, SUBLN_EPS = 1e-5f;
constexpr int NPHASE = 17;

constexpr size_t MiB = 1u << 20;
constexpr size_t WS_CTL = 0, CTL_ZERO_BYTES = 1 * MiB;
constexpr size_t WS_MOD = 1 * MiB, WS_LAMT = WS_MOD + 64 * 1024, WS_MODP = WS_MOD + 128 * 1024;
constexpr size_t WS_IDX = 2 * MiB, WS_RW = WS_IDX + 512 * 1024, WS_SLOTPOS = 3 * MiB, WS_SORTED = WS_SLOTPOS + 512 * 1024;
constexpr size_t WS_LOGITS = 5 * MiB;
constexpr size_t WS_WIN = 21 * MiB, WS_WOUT = 25 * MiB, WS_WGLU = 27 * MiB, WS_WR = WS_WGLU + 512 * 1024, WS_W2T = 28 * MiB, WS_W13T = 32 * MiB;
constexpr size_t WS_EGU = 40 * MiB, WS_EDN = 297 * MiB;
constexpr size_t WS_XN8 = 200 * MiB;
constexpr size_t WS_XN = 426 * MiB;
constexpr size_t WS_QKV = 458 * MiB, WS_UBUF = 506 * MiB, WS_SLOC = 530 * MiB, WS_G = 546 * MiB, WS_O = 562 * MiB, WS_CONCAT = 594 * MiB;
constexpr size_t WS_HBUF = 458 * MiB, WS_Y = 532 * MiB, WS_X1 = 820 * MiB, WS_ELIST = 884 * MiB, WS_END = 902 * MiB;
static_assert(WS_HBUF + (size_t)(NSLOT_ALL + 256) * 512 <= WS_Y && WS_Y + (size_t)NSLOT_ALL * 2048 <= WS_X1, "ws map");
static_assert(WS_SORTED + (size_t)(NSLOT_ALL + 256) * 4 <= WS_LOGITS, "ws map 2");
constexpr int CW_BAR = 4096, CW_COUNTS = 16384, CW_CURSOR = 32768, CSTR = 64, CW_SUB = 49152, CW_AQ = 49152 + 64, CW_CQ = 49152 + 64 * 16;

constexpr int RING_OFF = 0, RING_BYTES = 135168;
constexpr int TAB_OFF = RING_BYTES;
constexpr int TAB_TOFF = TAB_OFF, TAB_OFFS = TAB_OFF + 1040, TAB_DESC = TAB_OFF + 2080;
constexpr int LDSCTL_OFF = RING_BYTES + 4096, MISC_OFF = LDSCTL_OFF + 320;
constexpr int LDS_BYTES = 147456;
static_assert(MISC_OFF + 128 <= LDS_BYTES, "LDS map");

#define GAS __attribute__((address_space(1)))
#define LAS __attribute__((address_space(3)))
typedef unsigned short bf16;
typedef unsigned v4u __attribute__((ext_vector_type(4)));
typedef unsigned v2u __attribute__((ext_vector_type(2)));
typedef float f32x4 __attribute__((ext_vector_type(4)));
typedef GAS unsigned gu32;
#define RLX_AGENT __ATOMIC_RELAXED, __HIP_MEMORY_SCOPE_AGENT
#define LDS_WAIT() asm volatile("s_waitcnt lgkmcnt(0)" ::: "memory")
#define VM_WAIT() asm volatile("s_waitcnt vmcnt(0)" ::: "memory")
__device__ __forceinline__ unsigned f2bf(float f) { unsigned u = __builtin_bit_cast(unsigned, f); return (u + 0x7fffu + ((u >> 16) & 1u)) >> 16; }
__device__ __forceinline__ unsigned pk2(float lo, float hi) { return f2bf(lo) | (f2bf(hi) << 16); }
__device__ __forceinline__ unsigned pk4_fp8(float a, float b, float c, float d) { int w = __builtin_amdgcn_cvt_pk_fp8_f32(a, b, 0, false); w = __builtin_amdgcn_cvt_pk_fp8_f32(c, d, w, true); return (unsigned)w; }
__device__ __forceinline__ float bflo(unsigned w) { return __builtin_bit_cast(float, w << 16); }
__device__ __forceinline__ float bfhi(unsigned w) { return __builtin_bit_cast(float, w & 0xffff0000u); }
__device__ __forceinline__ float sigm(float x) { return 1.f / (1.f + __expf(-x)); }
__device__ __forceinline__ float gelu_t(float x) { const float z = 0.7978845608028654f * (x + 0.044715f * x * x * x); const float th = 1.f - 2.f / (1.f + __expf(2.f * z)); return 0.5f * x * (1.f + th); }

#define XB_TMO      128
#define XB_XCNT(j)  (256  + 64 * (j))
#define XB_XSUB(j)  (1280 + 64 * (j))
#define XB_XGEN(j)  (2304 + 64 * (j))
#define XB_TOP      3328
#define XB_TOPGEN   3392
#define XCD_BAR_WORDS 3456
#define XB_SPIN_CAP (1u << 18)
__device__ __forceinline__ unsigned xb_ld(unsigned* p)              { return __hip_atomic_load(p, __ATOMIC_RELAXED, __HIP_MEMORY_SCOPE_AGENT); }
__device__ __forceinline__ unsigned xb_add(unsigned* p, unsigned v) { return __hip_atomic_fetch_add(p, v, __ATOMIC_RELAXED, __HIP_MEMORY_SCOPE_AGENT); }
__device__ __forceinline__ unsigned xb_xcc_id() { return (unsigned)__builtin_amdgcn_s_getreg((3 << 11) | 20) & 0xFu; }
#define XB_SPIN(cond, bar) do { unsigned _sp = 0; while (cond) { __builtin_amdgcn_s_sleep(1); \
    if ((++_sp & 255u) == 0u) { if (xb_ld(&(bar)[XB_TMO])) break; if (_sp > XB_SPIN_CAP) { atomicAdd(&(bar)[XB_TMO], 1u); break; } } } } while (0)
struct XcdBarrier { unsigned* bar; unsigned x; volatile LAS unsigned* st; };
__device__ __forceinline__ XcdBarrier xcd_barrier_post(unsigned* bar, volatile LAS unsigned* st) {
    XcdBarrier b; b.bar = bar; b.x = xb_xcc_id(); b.st = st;
    if (threadIdx.x == 0) (void)xb_add(&bar[XB_XCNT(b.x)], 1u);
    return b;
}
__device__ __forceinline__ void xcd_barrier_complete(unsigned* bar, unsigned x, unsigned& nloc, unsigned& nx) {
    const unsigned G = gridDim.x * gridDim.y * gridDim.z;
    unsigned sum, cnt, mine, sp = 0u;
    for (;;) {
        sum = 0u; cnt = 0u; mine = 0u;
#pragma unroll
        for (unsigned j = 0; j < 16; ++j) { const unsigned c = xb_ld(&bar[XB_XCNT(j)]); sum += c; cnt += (c > 0u) ? 1u : 0u; mine = (j == x) ? c : mine; }
        if (sum == G) break;
        __builtin_amdgcn_s_sleep(1);
        if ((++sp & 255u) == 0u) { if (xb_ld(&bar[XB_TMO])) break; if (sp > XB_SPIN_CAP) { atomicAdd(&bar[XB_TMO], 1u); break; } }
    }
    nloc = mine > 0u ? mine : 1u; nx = cnt > 0u ? cnt : 1u;
}
__device__ __forceinline__ void xcd_barrier(const XcdBarrier& b) {
    asm volatile("s_waitcnt vmcnt(0)" ::: "memory");
    __syncthreads();
    if (threadIdx.x == 0) {
        unsigned* bar = b.bar;
        __builtin_amdgcn_s_waitcnt(0);
        unsigned nloc = b.st[0], nx = b.st[1];
        if (nloc == 0u) { xcd_barrier_complete(bar, b.x, nloc, nx); b.st[0] = nloc; b.st[1] = nx; }
        const unsigned old = xb_add(&bar[XB_XSUB(b.x)], 1u);
        const unsigned gen = old / nloc;
        if (old + 1u == (gen + 1u) * nloc) {
            __builtin_amdgcn_fence(__ATOMIC_RELEASE, "agent");
            asm volatile("s_waitcnt vmcnt(0)" ::: "memory");
            const unsigned og = xb_add(&bar[XB_TOP], 1u);
            const unsigned tg = og / nx;
            if (og + 1u == (tg + 1u) * nx) xb_add(&bar[XB_TOPGEN], 1u);
            else XB_SPIN(xb_ld(&bar[XB_TOPGEN]) == tg, bar);
            __builtin_amdgcn_fence(__ATOMIC_ACQUIRE, "agent");
            xb_add(&bar[XB_XGEN(b.x)], 1u);
            asm volatile("s_waitcnt vmcnt(0)" ::: "memory");
        } else {
            XB_SPIN(xb_ld(&bar[XB_XGEN(b.x)]) == gen, bar);
            __builtin_amdgcn_fence(__ATOMIC_ACQUIRE, "agent");
            asm volatile("s_waitcnt vmcnt(0)" ::: "memory");
        }
    }
    __syncthreads();
}

struct Args { const float* in[32]; float* out; unsigned char* ws; int ph_lo, ph_hi, variant, pad; };

struct Frame {
    LAS unsigned char* lds; volatile LAS unsigned* MISC; gu32* ctl;
    int tid, lane, wave, vcu, G;
};
__device__ __forceinline__ float wave_sum(float v) {
#pragma unroll
    for (int o = 1; o < 64; o <<= 1) v += __shfl_xor(v, o);
    return v;
}

__device__ __forceinline__ float wave_fsum_dpp(float v) {
#define FS_(ctrl, rm) v += __int_as_float(__builtin_amdgcn_update_dpp(0, __float_as_int(v), ctrl, rm, 0xf, false))
    FS_(0x111, 0xf); FS_(0x112, 0xf); FS_(0x114, 0xf); FS_(0x118, 0xf); FS_(0x142, 0xa); FS_(0x143, 0xc);
#undef FS_
    return __int_as_float(__builtin_amdgcn_readlane(__float_as_int(v), 63));
}

struct TrJob { const float* W; bf16* WT; int N, Kd; };
__device__ __forceinline__ void tr_load(f32x4 (&v)[8], const float* W, int N, int k0, int n0, int lane) {
    const int kc = lane & 7, ng = lane >> 3;
#pragma unroll
    for (int j = 0; j < 8; ++j) v[j] = __builtin_nontemporal_load((const GAS f32x4*)(W + (size_t)(k0 + 8 * kc + j) * N + n0 + 4 * ng));
}
__device__ __forceinline__ void tr_store(const f32x4 (&v)[8], bf16* WT, int Kd, int k0, int drow0, int lane) {
    const int kc = lane & 7, ng = lane >> 3;
#pragma unroll
    for (int i = 0; i < 4; ++i) { v4u o; o.x = pg8::cvt_pk_bf16(v[0][i], v[1][i]); o.y = pg8::cvt_pk_bf16(v[2][i], v[3][i]); o.z = pg8::cvt_pk_bf16(v[4][i], v[5][i]); o.w = pg8::cvt_pk_bf16(v[6][i], v[7][i]);
        *(GAS v4u*)(WT + (size_t)(drow0 + 4 * ng + i) * Kd + k0 + 8 * kc) = o; }
}
struct TrItem { const float* W; bf16* WT; int N, Kd, k0, n0, drow0; };
struct cplx { float r, i; };
__device__ __forceinline__ cplx cmul(cplx a, cplx b) { return {a.r * b.r - a.i * b.i, a.r * b.i + a.i * b.r}; }
__device__ __forceinline__ void ssm_lam(const float* a_re, const float* a_im, const float* lstep, int g, int p, float& lre, float& lim, float& dt) {
    lre = fminf(a_re[g * 64 + p], -1e-4f); lim = a_im[g * 64 + p]; dt = __expf(lstep[g]);
}
__device__ __forceinline__ cplx ssm_pow(float lre, float lim, float dt, float j) { const float er = __expf(lre * dt * j); float sn, cs; sincosf(lim * dt * j, &sn, &cs); return {er * cs, er * sn}; }
__device__ __forceinline__ cplx ssm_coef(float lre, float lim, float dt) {
    const cplx lb = ssm_pow(lre, lim, dt, 1.f); const float nr = lb.r - 1.f, ni = lb.i, den = lre * lre + lim * lim; return {(nr * lre + ni * lim) / den, (ni * lre - nr * lim) / den};
}

constexpr int NB8 = 2 * 64 * 257;
constexpr int NCONV = 12;
constexpr int C8_ROUTER = 0, C8_GLU = 0, C8_SSM = 0;
constexpr int C8_P2 = NB8 - C8_ROUTER, C8_P1 = C8_P2 - C8_GLU, C8_P0 = C8_P1 - C8_SSM;
struct P0In { const float *c, *w_ada, *b_ada, *w_in, *w_out, *w_glu, *w_router, *w_gate, *w_up, *w_down, *ws_gate, *ws_up, *ws_down, *a_re, *a_im, *lstep, *b_re, *b_im, *c_re, *c_im; };
__device__ __forceinline__ void conv8_range(const P0In& I, unsigned char* ws, int lo, int hi, int slot, int nslots, int lane) {
    unsigned char* EGU8 = ws + WS_EGU;
    auto dec8 = [&](int q, const float*& W, unsigned char*& WT, int& k0, int& n0, int& drow0) { const int e = q >> 7, up = (q >> 6) & 1, kb = (q >> 3) & 7, nb = q & 7;
        W = (e < NE) ? (up ? I.w_up : I.w_gate) + (size_t)e * 1024 * 256 : (up ? I.ws_up : I.ws_gate); WT = EGU8 + (size_t)e * 512 * 1024; k0 = 128 * kb; n0 = 32 * nb; drow0 = (n0 >> 7) * 256 + up * 128 + (n0 & 127); };
    for (int it = lo + slot; it < hi; it += 2 * nslots) {
        f32x4 v[2][16]; const float* W[2]; unsigned char* WT[2]; int k0[2], n0[2], d0[2]; const int kc = lane & 7, ng = lane >> 3;
#pragma unroll
        for (int u = 0; u < 2; ++u) { const int q = it + u * nslots; if (q < hi) { dec8(q, W[u], WT[u], k0[u], n0[u], d0[u]);
#pragma unroll
            for (int j = 0; j < 16; ++j) v[u][j] = __builtin_nontemporal_load((const GAS f32x4*)(W[u] + (size_t)(k0[u] + 16 * kc + j) * 256 + n0[u] + 4 * ng)); } }
#pragma unroll
        for (int u = 0; u < 2; ++u) { const int q = it + u * nslots; if (q < hi) {
#pragma unroll
            for (int i = 0; i < 4; ++i) { v4u o;
#pragma unroll
                for (int d = 0; d < 4; ++d) { int w_ = __builtin_amdgcn_cvt_pk_fp8_f32(v[u][4 * d][i] * 64.f, v[u][4 * d + 1][i] * 64.f, 0, false); w_ = __builtin_amdgcn_cvt_pk_fp8_f32(v[u][4 * d + 2][i] * 64.f, v[u][4 * d + 3][i] * 64.f, w_, true); o[d] = (unsigned)w_; }
                *(GAS v4u*)(WT[u] + (size_t)(d0[u] + 4 * ng + i) * 1024 + k0[u] + 16 * kc) = o; } } }
    }
}

__device__ __forceinline__ void conv_queues(const P0In& I, unsigned char* ws, gu32* heads, int xg, int lane) {
    { unsigned char* EGU8 = ws + WS_EGU; constexpr int PER = (NB8 + 7) / 8; gu32* head = heads + 64 * xg;
      auto dec8 = [&](int q, const float*& W, unsigned char*& WT, int& k0, int& n0, int& drow0) { const int e = q >> 7, up = (q >> 6) & 1, kb = (q >> 3) & 7, nb = q & 7;
          W = (e < NE) ? (up ? I.w_up : I.w_gate) + (size_t)e * 1024 * 256 : (up ? I.ws_up : I.ws_gate); WT = EGU8 + (size_t)e * 512 * 1024; k0 = 128 * kb; n0 = 32 * nb; drow0 = (n0 >> 7) * 256 + up * 128 + (n0 & 127); };
      for (;;) {
          int i0 = 0; if (lane == 0) i0 = (int)__hip_atomic_fetch_add(head, 3u, RLX_AGENT); i0 = __builtin_amdgcn_readfirstlane(i0);
          if (i0 >= PER) break;
          f32x4 v[3][16]; const float* W[3]; unsigned char* WT[3]; int k0[3], n0[3], d0[3]; const int kc = lane & 7, ng = lane >> 3;
#pragma unroll
          for (int u = 0; u < 3; ++u) { const int q = 8 * (i0 + u) + xg; if (q < NB8) { dec8(q, W[u], WT[u], k0[u], n0[u], d0[u]);
#pragma unroll
              for (int j = 0; j < 16; ++j) v[u][j] = __builtin_nontemporal_load((const GAS f32x4*)(W[u] + (size_t)(k0[u] + 16 * kc + j) * 256 + n0[u] + 4 * ng)); } }
#pragma unroll
          for (int u = 0; u < 3; ++u) { const int q = 8 * (i0 + u) + xg; if (q < NB8) {
#pragma unroll
              for (int i = 0; i < 4; ++i) { v4u o;
#pragma unroll
                  for (int d = 0; d < 4; ++d) { int w_ = __builtin_amdgcn_cvt_pk_fp8_f32(v[u][4 * d][i] * 64.f, v[u][4 * d + 1][i] * 64.f, 0, false); w_ = __builtin_amdgcn_cvt_pk_fp8_f32(v[u][4 * d + 2][i] * 64.f, v[u][4 * d + 3][i] * 64.f, w_, true); o[d] = (unsigned)w_; }
                  *(GAS v4u*)(WT[u] + (size_t)(d0[u] + 4 * ng + i) * 1024 + k0[u] + 16 * kc) = o; } } }
      } }
    { unsigned char* EDN8 = ws + WS_EDN; constexpr int ND = 257 * 64, PER = (ND + 7) / 8; gu32* head = heads + 64 * (8 + xg);
      for (;;) {
          int i0 = 0; if (lane == 0) i0 = (int)__hip_atomic_fetch_add(head, 3u, RLX_AGENT); i0 = __builtin_amdgcn_readfirstlane(i0);
          if (i0 >= PER) break;
          f32x4 v[3][16]; unsigned char* WT[3]; const int kc = lane & 7, ng = lane >> 3;
#pragma unroll
          for (int u = 0; u < 3; ++u) { const int q = 8 * (i0 + u) + xg; if (q < ND) { const int e = q >> 6, r = q & 63, kb = r >> 5, nb = r & 31;
              const float* W = ((e < NE) ? I.w_down + (size_t)e * 256 * 1024 : I.ws_down) + (size_t)(128 * kb + 16 * kc) * 1024 + 32 * nb + 4 * ng;
              WT[u] = EDN8 + (size_t)e * 1024 * 256 + (size_t)(32 * nb + 4 * ng) * 256 + 128 * kb + 16 * kc;
#pragma unroll
              for (int j = 0; j < 16; ++j) v[u][j] = __builtin_nontemporal_load((const GAS f32x4*)(W + (size_t)j * 1024)); } }
#pragma unroll
          for (int u = 0; u < 3; ++u) { const int q = 8 * (i0 + u) + xg; if (q < ND) {
#pragma unroll
              for (int i = 0; i < 4; ++i) { v4u o;
#pragma unroll
                  for (int d = 0; d < 4; ++d) { int w_ = __builtin_amdgcn_cvt_pk_fp8_f32(v[u][4 * d][i] * 64.f, v[u][4 * d + 1][i] * 64.f, 0, false); w_ = __builtin_amdgcn_cvt_pk_fp8_f32(v[u][4 * d + 2][i] * 64.f, v[u][4 * d + 3][i] * 64.f, w_, true); o[d] = (unsigned)w_; }
                  *(GAS v4u*)(WT[u] + (size_t)i * 256) = o; } } }
      } }
}
__device__ __forceinline__ void p0_prologue(Frame& F, const P0In& I, unsigned char* ws, int variant) {
    const int gw = F.vcu * NWAVES + F.wave, NGW = F.G * NWAVES, lane = F.lane;
    float* modp = (float*)(ws + WS_MODP); float* lamT = (float*)(ws + WS_LAMT);
    bf16* Win_t = (bf16*)(ws + WS_WIN); bf16* Wout_t = (bf16*)(ws + WS_WOUT); bf16* Wglu_t = (bf16*)(ws + WS_WGLU); bf16* Wr_t = (bf16*)(ws + WS_WR);
    bf16* W2t = (bf16*)(ws + WS_W2T); bf16* W13t = (bf16*)(ws + WS_W13T); bf16* EGU = (bf16*)(ws + WS_EGU); bf16* EDN = (bf16*)(ws + WS_EDN);
    int* sorted = (int*)(ws + WS_SORTED);
    constexpr int I_MOD = 96 * 16, I_S1 = 32 * 31, I_S2 = 32 * 16, I_S3 = 32 * 16, I_MISC = 1;
    constexpr int NITEMS = I_MOD + I_S1 + I_S2 + I_S3 + I_MISC;
    if (!(variant & 32)) for (int it = gw; it < NITEMS; it += NGW) {
        int r = it;
        if (r < I_S1) {
            const int g = r / 31, d = r % 31 - 15; const int c = lane >> 2, cp0 = (lane & 3) * 4;
            float kv[4] = {0.f, 0.f, 0.f, 0.f};
            if (d >= 0) {
                float lre, lim, dt; ssm_lam(I.a_re, I.a_im, I.lstep, g, lane, lre, lim, dt);
                const cplx z = cmul(ssm_pow(lre, lim, dt, (float)d), ssm_coef(lre, lim, dt));
                f32x4 br[4], bi[4]; float qr_[16], qi_[16];
#pragma unroll
                for (int j = 0; j < 4; ++j) { br[j] = *(const GAS f32x4*)(I.b_re + (g * 64 + lane) * 16 + 4 * j); bi[j] = *(const GAS f32x4*)(I.b_im + (g * 64 + lane) * 16 + 4 * j); }
#pragma unroll
                for (int cc = 0; cc < 16; ++cc) { const cplx q = cmul((cplx){I.c_re[(g * 16 + cc) * 64 + lane], I.c_im[(g * 16 + cc) * 64 + lane]}, z); qr_[cc] = q.r; qi_[cc] = q.i; }
#pragma unroll
                for (int cc = 0; cc < 16; ++cc)
#pragma unroll
                    for (int j = 0; j < 4; ++j)
#pragma unroll
                        for (int i = 0; i < 4; ++i) { const float tot = wave_fsum_dpp(qr_[cc] * br[j][i] - qi_[cc] * bi[j][i]);
                            if (lane == cc * 4 + j) kv[i] = tot; }
            }
            v2u o; o.x = pk2(kv[0], kv[1]); o.y = pk2(kv[2], kv[3]);
            for (int t = 0; t < 16; ++t) { const int s = t - d; if (s < 0 || s > 15) continue;
                *(GAS v2u*)(W13t + (size_t)(g * 256 + t * 16 + c) * 384 + s * 16 + cp0) = o; }
            continue; }
        r -= I_S1;
        if (r < I_S2) {
            const int g = r >> 4, t = r & 15; float lre, lim, dt; ssm_lam(I.a_re, I.a_im, I.lstep, g, lane, lre, lim, dt);
            const cplx pw = ssm_pow(lre, lim, dt, (float)(t + 1));
            for (int c = 0; c < 16; ++c) { const cplx cc = {I.c_re[(g * 16 + c) * 64 + lane], I.c_im[(g * 16 + c) * 64 + lane]}; const cplx q = cmul(cc, pw);
                *(GAS unsigned*)(W13t + (size_t)(g * 256 + t * 16 + c) * 384 + 256 + 2 * lane) = pk2(q.r, -q.i); }
            continue; }
        r -= I_S2;
        if (r < I_S3) {
            const int g = r >> 4, s = r & 15; float lre, lim, dt; ssm_lam(I.a_re, I.a_im, I.lstep, g, lane, lre, lim, dt);
            const cplx z = cmul(ssm_pow(lre, lim, dt, (float)(15 - s)), ssm_coef(lre, lim, dt));
            unsigned wr_[8], wi_[8];
#pragma unroll
            for (int c2 = 0; c2 < 8; ++c2) { const float br0 = I.b_re[(g * 64 + lane) * 16 + 2 * c2], bi0 = I.b_im[(g * 64 + lane) * 16 + 2 * c2], br1 = I.b_re[(g * 64 + lane) * 16 + 2 * c2 + 1], bi1 = I.b_im[(g * 64 + lane) * 16 + 2 * c2 + 1];
                wr_[c2] = pk2(z.r * br0 - z.i * bi0, z.r * br1 - z.i * bi1); wi_[c2] = pk2(z.r * bi0 + z.i * br0, z.r * bi1 + z.i * br1); }
            GAS v4u* dr = (GAS v4u*)(W2t + (size_t)(g * 256 + 2 * lane) * 256 + s * 16); GAS v4u* di = (GAS v4u*)(W2t + (size_t)(g * 256 + 2 * lane + 1) * 256 + s * 16);
            dr[0] = (v4u){wr_[0], wr_[1], wr_[2], wr_[3]}; dr[1] = (v4u){wr_[4], wr_[5], wr_[6], wr_[7]};
            di[0] = (v4u){wi_[0], wi_[1], wi_[2], wi_[3]}; di[1] = (v4u){wi_[4], wi_[5], wi_[6], wi_[7]};
            if (s == 0) { const cplx l16 = ssm_pow(lre, lim, dt, 16.f); lamT[(g * 64 + lane) * 2] = l16.r; lamT[(g * 64 + lane) * 2 + 1] = l16.i; }
            continue; }
        r -= I_S3;
        if (r < I_MISC) { for (int i = lane; i < 256; i += 64) sorted[NSLOT_ALL + i] = 0; continue; }
        r -= I_MISC;
        if (r < I_MOD) {
            const int jb = r % 96, ks = r / 96, j = jb * 64 + lane; float a0 = 0.f, a1 = 0.f;
#pragma unroll 16
            for (int kk = 0; kk < 64; ++kk) { const int k = ks * 64 + kk; const float w = I.w_ada[(size_t)k * 6 * D_ + j]; const float c0 = I.c[k], c1 = I.c[D_ + k];
                a0 += (c0 / (1.f + __expf(-c0))) * w; a1 += (c1 / (1.f + __expf(-c1))) * w; }
            if (ks == 0) { const float bb = I.b_ada[j]; a0 += bb; a1 += bb; }
            modp[(size_t)(ks * 2 + 0) * 6 * D_ + j] = a0; modp[(size_t)(ks * 2 + 1) * 6 * D_ + j] = a1; }
    }
    constexpr int T_WIN = 16 * 64, T_WOUT = 16 * 32, T_WGLU = 8 * 16, T_WR = 16 * 8, T_SH = 128, T_E = 256 * 128;
    constexpr int NTR = T_WIN + T_WOUT + T_WGLU + T_WR;
    auto decode = [&](int r, TrItem& t) {
        auto plain = [&](const float* W, int K, int N, bf16* WT, int q) { const int nblk = N / 32, kb = q / nblk, nb = q % nblk; t.W = W; t.WT = WT; t.N = N; t.Kd = K; t.k0 = 64 * kb; t.n0 = 32 * nb; t.drow0 = 32 * nb; };
        auto gu = [&](const float* W, bf16* WTe, int up, int q) { const int kb = q >> 3, nb = q & 7, n0 = 32 * nb; t.W = W; t.WT = WTe; t.N = 256; t.Kd = 1024; t.k0 = 64 * kb; t.n0 = n0; t.drow0 = (n0 >> 7) * 256 + up * 128 + (n0 & 127); };
        if (r < T_WIN) { plain(I.w_in, 1024, 2048, Win_t, r); return; } r -= T_WIN;
        if (r < T_WOUT) { plain(I.w_out, 1024, 1024, Wout_t, r); return; } r -= T_WOUT;
        if (r < T_WGLU) { plain(I.w_glu, 512, 512, Wglu_t, r); return; } r -= T_WGLU;
        if (r < T_WR) { plain(I.w_router, 1024, 256, Wr_t, r); return; } r -= T_WR;
        if (r < T_SH) { plain(I.ws_down, 256, 1024, EDN + (size_t)256 * 1024 * 256, r); return; } r -= T_SH;
        { const int e = r >> 7; plain(I.w_down + (size_t)e * 256 * 1024, 256, 1024, EDN + (size_t)e * 1024 * 256, r & 127); }
    };
    if (!(variant & 16)) for (int it = gw; it < NTR; it += 4 * NGW) {
        f32x4 v[4][8]; TrItem t[4];
#pragma unroll
        for (int u = 0; u < 4; ++u) { const int q = it + u * NGW; if (q < NTR) { decode(q, t[u]); tr_load(v[u], t[u].W, t[u].N, t[u].k0, t[u].n0, lane); } }
#pragma unroll
        for (int u = 0; u < 4; ++u) { const int q = it + u * NGW; if (q < NTR) tr_store(v[u], t[u].WT, t[u].Kd, t[u].k0, t[u].drow0, lane); }
    }
}

template <int NPART> __device__ __forceinline__ void norm_mod_rows(Frame& F, const float* x, const float* g, const float* mod, int shift_off, int scale_off, bf16* out, unsigned char* out8 = nullptr) {
    const int gw = F.vcu * NWAVES + F.wave, NGW = F.G * NWAVES, lane = F.lane;
    for (int b = 0; b < B_; ++b) {
        f32x4 gs[4], sh[4];
#pragma unroll
        for (int j = 0; j < 4; ++j) { const int c = 4 * lane + 256 * j; const f32x4 gg = *(const GAS f32x4*)(g + c); f32x4 sc = *(const GAS f32x4*)(mod + b * 6 * D_ + scale_off + c), sv = *(const GAS f32x4*)(mod + b * 6 * D_ + shift_off + c);
#pragma unroll
            for (int q = 1; q < NPART; ++q) { sc += *(const GAS f32x4*)(mod + (size_t)(q * 2 + b) * 6 * D_ + scale_off + c); sv += *(const GAS f32x4*)(mod + (size_t)(q * 2 + b) * 6 * D_ + shift_off + c); }
            gs[j] = gg * (sc + 1.0f); sh[j] = sv; }
        for (int m = b * L_ + gw; m < (b + 1) * L_; m += NGW) {
            const GAS f32x4* xr = (const GAS f32x4*)(x + (size_t)m * D_) + lane;
            f32x4 v[4]; float s = 0.f;
#pragma unroll
            for (int j = 0; j < 4; ++j) { v[j] = xr[64 * j]; s += (v[j].x * v[j].x + v[j].y * v[j].y) + (v[j].z * v[j].z + v[j].w * v[j].w); }
            const float rstd = rsqrtf(wave_sum(s) * (1.f / D_) + NORM_EPS);
            GAS v2u* o8 = (GAS v2u*)(out + (size_t)m * D_) + lane;
#pragma unroll
            for (int j = 0; j < 4; ++j) { const f32x4 y = v[j] * rstd * gs[j] + sh[j]; v2u w; w.x = pk2(y.x, y.y); w.y = pk2(y.z, y.w); o8[64 * j] = w;
                if (out8) *(GAS unsigned*)(out8 + (size_t)m * D_ + 4 * lane + 256 * j) = pk4_fp8(y.x, y.y, y.z, y.w); }
        }
    }
}

using pg8::Unit;
struct GridOrder {
    const char* A; const char* Bt; int lda, ldb, nM, nN, nwg, G, c;
    __device__ __forceinline__ bool next(int i, Unit& u) const {
        const long L = (long)i * G + c; if (L >= nwg) return false;
        int wgid = (int)L; { const int q = nwg / 8, r = nwg % 8, xcd = wgid % 8, off = wgid / 8; wgid = (xcd < r ? xcd * (q + 1) : r * (q + 1) + (xcd - r) * q) + off; }
        const int nig = 8 * nN, gid = wgid / nig, fm = gid * 8, gsz = (nM - fm) < 8 ? (nM - fm) : 8;
        u.pm = fm + ((wgid % nig) % gsz); u.pn = (wgid % nig) / gsz; u.r0 = 0; u.nv = 256; u.gath = nullptr;
        u.A = A + (size_t)u.pm * 256 * lda * 2; u.B = Bt + (size_t)u.pn * 256 * ldb * 2; return true;
    }
};
struct GroupOrder {
    const char* A; const char* Bt; int lda, ldb, nwg, G, c;
    __device__ __forceinline__ bool next(int i, Unit& u) const {
        const int L = i * G + c; if (L >= nwg) return false;
        u.pm = L; u.pn = L >> 2; u.r0 = 0; u.nv = 256; u.gath = nullptr;
        u.A = A + (size_t)L * 256 * lda * 2; u.B = Bt + (size_t)(L >> 2) * 256 * ldb * 2; return true;
    }
};
struct PairOrder {
    const char* A; const char* Bt; int lda, ldb, L0;
    __device__ __forceinline__ bool next(int i, Unit& u) const {
        if (i >= 2) return false; const int L = L0 + i;
        u.pm = L; u.pn = L >> 2; u.r0 = 0; u.nv = 256; u.gath = nullptr;
        u.A = A + (size_t)L * 256 * lda * 2; u.B = Bt + (size_t)(L >> 2) * 256 * ldb * 2; return true;
    }
};
__device__ __forceinline__ void wg_handover(Frame& F) {
    asm volatile("s_waitcnt vmcnt(0)" ::: "memory"); __syncthreads();
    if (F.tid == 0) { __builtin_amdgcn_fence(__ATOMIC_ACQUIRE, "agent"); asm volatile("s_waitcnt vmcnt(0)" ::: "memory"); }
    __syncthreads();
}
struct GluOrder {
    const char* A; const char* Bt; int sg;
    __device__ __forceinline__ bool next(int i, Unit& u) const {
        if (i >= 2) return false; const int L = sg + 64 * i;
        u.pm = L >> 1; u.pn = L & 1; u.r0 = 0; u.nv = 256; u.gath = nullptr; u.A = A + (size_t)u.pm * 256 * 512 * 2; u.B = Bt + (size_t)u.pn * 256 * 512 * 2; return true;
    }
};
__device__ __forceinline__ void sub_barrier(Frame& F, gu32* cnt, unsigned target) {
    asm volatile("s_waitcnt vmcnt(0)" ::: "memory"); __syncthreads();
    if (F.tid == 0) {
        __builtin_amdgcn_fence(__ATOMIC_RELEASE, "agent"); asm volatile("s_waitcnt vmcnt(0)" ::: "memory");
        (void)__hip_atomic_fetch_add(cnt, 1u, RLX_AGENT);
        unsigned sp = 0; while (__hip_atomic_load(cnt, RLX_AGENT) < target) { __builtin_amdgcn_s_sleep(2); if (++sp > (1u << 21)) break; }
        __builtin_amdgcn_fence(__ATOMIC_ACQUIRE, "agent"); asm volatile("s_waitcnt vmcnt(0)" ::: "memory");
    }
    __syncthreads();
}
template <int NJ, bool GATH> struct ExpertOrder {
    const LAS int* toff; const LAS int* offs; const LAS int* desc; const char* A; const char* Bt; const int* sorted; int G, c, ntot;
    __device__ __forceinline__ bool next(int i, Unit& u) const {
        const int L = i * G + c; if (L >= ntot) return false;
        const int e = desc[2 * i], mt = desc[2 * i + 1], j = L % NJ;
        const int o0 = offs[e], cnt = offs[e + 1] - o0;
        u.pm = e; u.pn = j; u.r0 = o0 + mt * 256; u.nv = cnt - mt * 256;
        if (GATH) { u.A = A; u.gath = sorted + u.r0; u.B = Bt + ((size_t)e * 2 + j) * 256 * 1024 * 2; }
        else { u.A = A + (size_t)u.r0 * 256 * 2; u.gath = nullptr; u.B = Bt + ((size_t)e * 4 + j) * 256 * 256 * 2; }
        return true;
    }
};
template <int NJ> __device__ __forceinline__ int build_expert_tables(Frame& F, const gu32* counts, int maxdesc) {
    LAS int* toff = (LAS int*)(F.lds + TAB_TOFF); LAS int* offs = (LAS int*)(F.lds + TAB_OFFS); LAS int* desc = (LAS int*)(F.lds + TAB_DESC);
    __syncthreads();
    if (F.wave == 0) {
        const int l = F.lane; int c[4], t[4]; int cs = 0, ts = 0;
#pragma unroll
        for (int i = 0; i < 4; ++i) { c[i] = (int)__hip_atomic_load(counts + (4 * l + i) * CSTR, RLX_AGENT); t[i] = (c[i] + 255) >> 8; cs += c[i]; ts += t[i]; }
        int ce = cs, te = ts;
#pragma unroll
        for (int o = 1; o < 64; o <<= 1) { const int a = __shfl_up(ce, o), b = __shfl_up(te, o); if (l >= o) { ce += a; te += b; } }
        int co = ce - cs, to = te - ts;
#pragma unroll
        for (int i = 0; i < 4; ++i) { offs[4 * l + i] = co; toff[4 * l + i] = to; co += c[i]; to += t[i]; }
        if (l == 63) { offs[256] = co; toff[256] = to; offs[257] = co + M_; toff[257] = to + M_ / 256; }
    }
    __syncthreads();
    const int ntiles = toff[257];
    if (F.tid < maxdesc) {
        const int L = F.tid * F.G + F.vcu, T = L / NJ; int e = 0, mt = 0;
        if (T < ntiles) { int lo = 0, hi = 257;
            while (hi - lo > 1) { const int mid = (lo + hi) >> 1; if (toff[mid] <= T) lo = mid; else hi = mid; }
            e = lo; mt = T - toff[lo]; }
        desc[2 * F.tid] = e; desc[2 * F.tid + 1] = mt;
    }
    __syncthreads();
    return ntiles * NJ;
}

using pg8::f32x4; using pg8::u32x4; using pg8::cvt_pk_bf16;
#define EPI_ARGS const f32x4 (&acc)[2][2][4][2], const Unit& u, int wr, int wc, int fr, int fq
struct EpiProj { static constexpr bool PERM = true; bf16* QKV; bf16* Ubuf; float c2;
    __device__ __forceinline__ void operator()(EPI_ARGS) const {
        const int colt = u.pn * 256; const float sc = (colt < 512) ? c2 : 1.f;
#pragma unroll
        for (int ai = 0; ai < 2; ++ai)
#pragma unroll
            for (int m = 0; m < 4; ++m) { const int row = u.pm * 256 + ai * 128 + wr * 64 + m * 16 + fr;
#pragma unroll
                for (int bj = 0; bj < 2; ++bj) { const int C = colt + bj * 128 + wc * 32 + 8 * fq; const f32x4 v0 = acc[ai][bj][m][0] * sc, v1 = acc[ai][bj][m][1] * sc;
                    u32x4 w; w.x = cvt_pk_bf16(v0[0], v0[1]); w.y = cvt_pk_bf16(v0[2], v0[3]); w.z = cvt_pk_bf16(v1[0], v1[1]); w.w = cvt_pk_bf16(v1[2], v1[3]);
                    if (colt < 1536) *(u32x4*)(QKV + (size_t)row * 1536 + C) = w;
                    else { const int ch = C - 1536, g = ch >> 4, cc = ch & 15; *(u32x4*)(Ubuf + ((size_t)(g * 1024 + (row >> 4)) * 384 + (row & 15) * 16 + cc)) = w; } } }
    } };
struct EpiSloc { static constexpr bool PERM = false; float* Sloc;
    __device__ __forceinline__ void operator()(EPI_ARGS) const {
#pragma unroll
        for (int ai = 0; ai < 2; ++ai)
#pragma unroll
            for (int m = 0; m < 4; ++m) { const int row = u.pm * 256 + ai * 128 + wr * 64 + m * 16 + fr;
#pragma unroll
                for (int n = 0; n < 2; ++n) *(f32x4*)(Sloc + (size_t)row * 128 + wc * 32 + 16 * n + 4 * fq) = acc[ai][0][m][n]; }
    } };
struct EpiSsm2 { static constexpr bool PERM = true; const bf16* Ubuf; const float* dskip; bf16* G;
    __device__ __forceinline__ void operator()(EPI_ARGS) const {
        const int g = u.pm >> 2;
#pragma unroll
        for (int ai = 0; ai < 2; ++ai)
#pragma unroll
            for (int m = 0; m < 4; ++m) { const int R = u.pm * 256 + ai * 128 + wr * 64 + m * 16 + fr, nch = R & 1023;
#pragma unroll
                for (int bj = 0; bj < 2; ++bj) { const int c0 = bj * 128 + wc * 32 + 8 * fq, t = c0 >> 4, cc = c0 & 15;
                    const u32x4 uu = *(const u32x4*)(Ubuf + (size_t)R * 384 + c0); const f32x4 d0 = *(const f32x4*)(dskip + g * 16 + cc), d1 = *(const f32x4*)(dskip + g * 16 + cc + 4);
                    const f32x4 a0 = acc[ai][bj][m][0], a1 = acc[ai][bj][m][1];
                    const float y0 = a0[0] + d0[0] * bflo(uu.x), y1 = a0[1] + d0[1] * bfhi(uu.x), y2 = a0[2] + d0[2] * bflo(uu.y), y3 = a0[3] + d0[3] * bfhi(uu.y);
                    const float y4 = a1[0] + d1[0] * bflo(uu.z), y5 = a1[1] + d1[1] * bfhi(uu.z), y6 = a1[2] + d1[2] * bflo(uu.w), y7 = a1[3] + d1[3] * bfhi(uu.w);
                    u32x4 w; w.x = cvt_pk_bf16(gelu_t(y0), gelu_t(y1)); w.y = cvt_pk_bf16(gelu_t(y2), gelu_t(y3)); w.z = cvt_pk_bf16(gelu_t(y4), gelu_t(y5)); w.w = cvt_pk_bf16(gelu_t(y6), gelu_t(y7));
                    *(u32x4*)(G + (size_t)(nch * 16 + t) * 512 + g * 16 + cc) = w; } }
    } };
struct EpiGlu { static constexpr bool PERM = true; const bf16* G; const float* bias; bf16* concat;
    __device__ __forceinline__ void operator()(EPI_ARGS) const {
#pragma unroll
        for (int ai = 0; ai < 2; ++ai)
#pragma unroll
            for (int m = 0; m < 4; ++m) { const int row = u.pm * 256 + ai * 128 + wr * 64 + m * 16 + fr;
#pragma unroll
                for (int bj = 0; bj < 2; ++bj) { const int C = u.pn * 256 + bj * 128 + wc * 32 + 8 * fq;
                    const u32x4 gg = *(const u32x4*)(G + (size_t)row * 512 + C); const f32x4 b0 = *(const f32x4*)(bias + C), b1 = *(const f32x4*)(bias + C + 4);
                    const f32x4 a0 = acc[ai][bj][m][0] + b0, a1 = acc[ai][bj][m][1] + b1;
                    u32x4 w; w.x = cvt_pk_bf16(bflo(gg.x) * sigm(a0[0]), bfhi(gg.x) * sigm(a0[1])); w.y = cvt_pk_bf16(bflo(gg.y) * sigm(a0[2]), bfhi(gg.y) * sigm(a0[3]));
                    w.z = cvt_pk_bf16(bflo(gg.z) * sigm(a1[0]), bfhi(gg.z) * sigm(a1[1])); w.w = cvt_pk_bf16(bflo(gg.w) * sigm(a1[2]), bfhi(gg.w) * sigm(a1[3]));
                    *(u32x4*)(concat + (size_t)row * 1024 + 512 + C) = w; } }
    } };
struct EpiRes { static constexpr bool PERM = false; const float* x; const float* mod; float* out;
    __device__ __forceinline__ void operator()(EPI_ARGS) const {
#pragma unroll
        for (int ai = 0; ai < 2; ++ai)
#pragma unroll
            for (int m = 0; m < 4; ++m) { const int row = u.pm * 256 + ai * 128 + wr * 64 + m * 16 + fr; const float* gp = mod + (row >> 13) * 6 * D_ + 2 * D_;
#pragma unroll
                for (int bj = 0; bj < 2; ++bj)
#pragma unroll
                    for (int n = 0; n < 2; ++n) { const int C = u.pn * 256 + bj * 128 + wc * 32 + 16 * n + 4 * fq; const size_t off = (size_t)row * D_ + C;
                        *(f32x4*)(out + off) = *(const f32x4*)(x + off) + *(const f32x4*)(gp + C) * acc[ai][bj][m][n]; } }
    } };
struct EpiLogits { static constexpr bool PERM = false; float* logits;
    __device__ __forceinline__ void operator()(EPI_ARGS) const {
#pragma unroll
        for (int ai = 0; ai < 2; ++ai)
#pragma unroll
            for (int m = 0; m < 4; ++m) { const int row = u.pm * 256 + ai * 128 + wr * 64 + m * 16 + fr;
#pragma unroll
                for (int bj = 0; bj < 2; ++bj)
#pragma unroll
                    for (int n = 0; n < 2; ++n) *(f32x4*)(logits + (size_t)row * 256 + bj * 128 + wc * 32 + 16 * n + 4 * fq) = acc[ai][bj][m][n]; }
    } };
struct EpiGateUp { static constexpr bool PERM = true; bf16* Hbuf; float s;
    __device__ __forceinline__ void operator()(EPI_ARGS) const {
#pragma unroll
        for (int ai = 0; ai < 2; ++ai)
#pragma unroll
            for (int m = 0; m < 4; ++m) { const int rr = ai * 128 + wr * 64 + m * 16 + fr;
                if (rr < u.nv) { const f32x4 g0 = acc[ai][0][m][0] * s, g1 = acc[ai][0][m][1] * s, u0 = acc[ai][1][m][0] * s, u1 = acc[ai][1][m][1] * s;
                    u32x4 w; w.x = cvt_pk_bf16(g0[0] * sigm(g0[0]) * u0[0], g0[1] * sigm(g0[1]) * u0[1]); w.y = cvt_pk_bf16(g0[2] * sigm(g0[2]) * u0[2], g0[3] * sigm(g0[3]) * u0[3]);
                    w.z = cvt_pk_bf16(g1[0] * sigm(g1[0]) * u1[0], g1[1] * sigm(g1[1]) * u1[1]); w.w = cvt_pk_bf16(g1[2] * sigm(g1[2]) * u1[2], g1[3] * sigm(g1[3]) * u1[3]);
                    *(u32x4*)(Hbuf + (size_t)(u.r0 + rr) * 256 + u.pn * 128 + wc * 32 + 8 * fq) = w; } }
    } };
struct EpiDown { static constexpr bool PERM = true; bf16* Y; int variant;
    __device__ __forceinline__ void operator()(EPI_ARGS) const {
#pragma unroll
        for (int ai = 0; ai < 2; ++ai)
#pragma unroll
            for (int m = 0; m < 4; ++m) { const int rr = ai * 128 + wr * 64 + m * 16 + fr;
                if (rr < u.nv && !(variant & 4)) {
#pragma unroll
                    for (int bj = 0; bj < 2; ++bj) { const f32x4 v0 = acc[ai][bj][m][0], v1 = acc[ai][bj][m][1];
                        u32x4 w; w.x = cvt_pk_bf16(v0[0], v0[1]); w.y = cvt_pk_bf16(v0[2], v0[3]); w.z = cvt_pk_bf16(v1[0], v1[1]); w.w = cvt_pk_bf16(v1[2], v1[3]);
                        *(u32x4*)(Y + (size_t)(u.r0 + rr) * 1024 + u.pn * 256 + bj * 128 + wc * 32 + 8 * fq) = w; } } }
    } };

struct EpiGateUp8 { static constexpr bool PERM = true; unsigned char* H8;
    __device__ __forceinline__ void operator()(EPI_ARGS) const {
        const float s = 1.f / 64.f;
#pragma unroll
        for (int ai = 0; ai < 2; ++ai)
#pragma unroll
            for (int m = 0; m < 4; ++m) { const int rr = ai * 128 + wr * 64 + m * 16 + fr;
                if (rr < u.nv) { const f32x4 g0 = acc[ai][0][m][0] * s, g1 = acc[ai][0][m][1] * s, u0 = acc[ai][1][m][0] * (s * 16.f), u1 = acc[ai][1][m][1] * (s * 16.f);
                    v2u w; w.x = pk4_fp8(g0[0] * sigm(g0[0]) * u0[0], g0[1] * sigm(g0[1]) * u0[1], g0[2] * sigm(g0[2]) * u0[2], g0[3] * sigm(g0[3]) * u0[3]);
                    w.y = pk4_fp8(g1[0] * sigm(g1[0]) * u1[0], g1[1] * sigm(g1[1]) * u1[1], g1[2] * sigm(g1[2]) * u1[2], g1[3] * sigm(g1[3]) * u1[3]);
                    *(v2u*)(H8 + (size_t)(u.r0 + rr) * 256 + u.pn * 128 + wc * 32 + 8 * fq) = w; } }
    } };
struct ExpertOrderD8 {
    const LAS int* offs; const LAS int* desc; const char* A; const char* Bt; int G, c, ntot;
    __device__ __forceinline__ bool next(int i, Unit& u) const {
        const int L = i * G + c; if (L >= ntot) return false;
        const int e = desc[2 * i], mt = desc[2 * i + 1], j = L & 3;
        const int o0 = offs[e], cnt = offs[e + 1] - o0;
        u.pm = e; u.pn = j; u.r0 = o0 + mt * 256; u.nv = cnt - mt * 256; u.gath = nullptr; u.A = A + (size_t)u.r0 * 256; u.B = Bt + ((size_t)e * 4 + j) * 256 * 256; return true;
    }
};
struct EpiDown8 { static constexpr bool PERM = true; static constexpr bool PERM16 = true; unsigned char* Y8;
    __device__ __forceinline__ void operator()(EPI_ARGS) const {
#pragma unroll
        for (int ai = 0; ai < 2; ++ai)
#pragma unroll
            for (int m = 0; m < 4; ++m) { const int rr = ai * 128 + wr * 64 + m * 16 + fr;
                if (rr < u.nv) { const f32x4 a = acc[ai][0][m][0] * (1.f / 64.f), b = acc[ai][0][m][1] * (1.f / 64.f), c = acc[ai][1][m][0] * (1.f / 64.f), d = acc[ai][1][m][1] * (1.f / 64.f);
                    v4u w; w.x = pk4_fp8(a[0], a[1], a[2], a[3]); w.y = pk4_fp8(b[0], b[1], b[2], b[3]); w.z = pk4_fp8(c[0], c[1], c[2], c[3]); w.w = pk4_fp8(d[0], d[1], d[2], d[3]);
                    *(v4u*)(Y8 + (size_t)(u.r0 + rr) * 1024 + u.pn * 256 + wc * 64 + 16 * fq) = w; } }
    } };
struct ExpertOrder8 {
    const LAS int* offs; const LAS int* desc; const char* A; const char* Bt; const int* sorted; int G, c, ntot;
    __device__ __forceinline__ bool next(int i, Unit& u) const {
        const int L = i * G + c; if (L >= ntot) return false;
        const int e = desc[2 * i], mt = desc[2 * i + 1], j = L & 1;
        const int o0 = offs[e], cnt = offs[e + 1] - o0;
        u.pm = e; u.pn = j; u.r0 = o0 + mt * 256; u.nv = cnt - mt * 256; u.A = A; u.gath = sorted + e * 16384 + mt * 256; u.B = Bt + ((size_t)e * 2 + j) * 256 * 1024; return true;
    }
};
struct XW { const float *gate, *up, *down, *sgate, *sup, *sdown; };
template <int NJ, bool GUP> struct ExpertOrderF {
    const LAS int* offs; const LAS int* desc; const char* A; XW w; const int* sorted; int G, c, ntot, variant;
    __device__ __forceinline__ bool next(int i, mg::Unit& u) const {
        const int L = i * G + c; if (L >= ntot) return false;
        const int e = desc[2 * i], mt = desc[2 * i + 1], j = L % NJ;
        const int o0 = offs[e], cnt = offs[e + 1] - o0;
        u.pm = e; u.pn = j; u.r0 = o0 + mt * 256; u.nv = cnt - mt * 256;
        const int ew = (variant & 1) ? 0 : e; const int ra = (variant & 2) ? 0 : u.r0;
        if (GUP) { u.A = A; u.gath = sorted + ra;
            u.B0 = (ew < NE ? w.gate + (size_t)ew * 1024 * 256 : w.sgate) + j * 64; u.B1 = (ew < NE ? w.up + (size_t)ew * 1024 * 256 : w.sup) + j * 64; }
        else { u.A = A + (size_t)ra * 256 * 2; u.gath = nullptr; u.B0 = (ew < NE ? w.down + (size_t)ew * 256 * 1024 : w.sdown) + j * 128; u.B1 = u.B0; }
        return true;
    }
};
#define EPIN_ARGS const f32x4 (&acc)[2][4][2], const mg::Unit& u, int wr, int wc, int fr, int fq
struct EpiGateUpN { bf16* Hbuf; float s;
    __device__ __forceinline__ void operator()(EPIN_ARGS) const {
#pragma unroll
        for (int ai = 0; ai < 2; ++ai)
#pragma unroll
            for (int m = 0; m < 4; ++m) { const int rr = ai * 128 + wr * 64 + m * 16 + fr;
                if (rr < u.nv) { const f32x4 g = acc[ai][m][0] * s, v = acc[ai][m][1] * s;
                    pg8::u32x2 w; w.x = cvt_pk_bf16(g[0] * sigm(g[0]) * v[0], g[1] * sigm(g[1]) * v[1]); w.y = cvt_pk_bf16(g[2] * sigm(g[2]) * v[2], g[3] * sigm(g[3]) * v[3]);
                    *(pg8::u32x2*)(Hbuf + (size_t)(u.r0 + rr) * 256 + u.pn * 64 + wc * 16 + 4 * fq) = w; } }
    } };
struct EpiDownN { bf16* Y;
    __device__ __forceinline__ void operator()(EPIN_ARGS) const {
#pragma unroll
        for (int ai = 0; ai < 2; ++ai)
#pragma unroll
            for (int m = 0; m < 4; ++m) { const int rr = ai * 128 + wr * 64 + m * 16 + fr;
                if (rr < u.nv) { const f32x4 v0 = acc[ai][m][0], v1 = acc[ai][m][1];
                    u32x4 w; w.x = cvt_pk_bf16(v0[0], v0[1]); w.y = cvt_pk_bf16(v0[2], v0[3]); w.z = cvt_pk_bf16(v1[0], v1[1]); w.w = cvt_pk_bf16(v1[2], v1[3]);
                    *(u32x4*)(Y + (size_t)(u.r0 + rr) * 1024 + u.pn * 128 + wc * 32 + 8 * fq) = w; } }
    } };

__global__ void __launch_bounds__(NWAVES * 64, 2) mega_fwd(Args args) {
    extern __shared__ __attribute__((aligned(16))) unsigned char lds[];
    Frame F;
    F.lds = (LAS unsigned char*)lds; F.MISC = (volatile LAS unsigned*)(F.lds + MISC_OFF);
    F.tid = threadIdx.x; F.lane = F.tid & 63; F.wave = __builtin_amdgcn_readfirstlane(F.tid >> 6);
    F.G = gridDim.x; { const int bx = blockIdx.x; F.vcu = (F.G % 8 == 0) ? (bx % 8) * (F.G / 8) + bx / 8 : bx; }
    unsigned char* ws = args.ws; F.ctl = (gu32*)(ws + WS_CTL);
    for (int u = F.tid; u < (LDS_BYTES - LDSCTL_OFF) / 4; u += NWAVES * 64) ((LAS unsigned*)(F.lds + LDSCTL_OFF))[u] = 0u;
    __syncthreads();
    const int lo = args.ph_lo, hi = args.ph_hi;
    const bool multi = (hi - lo) > 1;
    XcdBarrier bar; bar.bar = (unsigned*)(F.ctl + CW_BAR); bar.x = 0; bar.st = nullptr;
    if (multi) bar = xcd_barrier_post((unsigned*)(F.ctl + CW_BAR), F.MISC + 8);
#ifndef PHASE_MASK
#define PHASE_MASK 0x1ffff
#endif
#define IN(k) (((PHASE_MASK >> (k)) & 1) && lo <= (k) && (k) < hi)
#ifndef REPEAT_MASK
#define REPEAT_MASK 0
#endif
#define NREP(k) ((((REPEAT_MASK) >> (k)) & 1) + 1)
#if REPEAT_MASK
#define PH(k) for (int rep_ = 0; rep_ < NREP(k); ++rep_) if (IN(k) && (rep_ == 0 || (xcd_barrier(bar), true)))
#else
#define PH(k) if (IN(k))
#endif
#define SEAM(k) do { if (IN(k) && IN((k) + 1)) xcd_barrier(bar); } while (0)
    const float* x = args.in[0]; float* out = args.out;
#define mod ((float*)(ws + WS_MOD))
#define lamT ((float*)(ws + WS_LAMT))
#define idx ((int*)(ws + WS_IDX))
#define rw ((float*)(ws + WS_RW))
#define slotpos ((int*)(ws + WS_SLOTPOS))
#define sorted ((int*)(ws + WS_SORTED))
#define logits ((float*)(ws + WS_LOGITS))
#define Win_t ((bf16*)(ws + WS_WIN))
#define Wout_t ((bf16*)(ws + WS_WOUT))
#define Wglu_t ((bf16*)(ws + WS_WGLU))
#define Wr_t ((bf16*)(ws + WS_WR))
#define W2t ((bf16*)(ws + WS_W2T))
#define W13t ((bf16*)(ws + WS_W13T))
#define EGU ((bf16*)(ws + WS_EGU))
#define EDN ((bf16*)(ws + WS_EDN))
#define XN ((bf16*)(ws + WS_XN))
#define QKV ((bf16*)(ws + WS_QKV))
#define Ubuf ((bf16*)(ws + WS_UBUF))
#define Sloc ((float*)(ws + WS_SLOC))
#define Gb ((bf16*)(ws + WS_G))
#define Ob ((bf16*)(ws + WS_O))
#define concat ((bf16*)(ws + WS_CONCAT))
#define Hbuf ((bf16*)(ws + WS_HBUF))
#define Yb ((bf16*)(ws + WS_Y))
#define X1 ((float*)(ws + WS_X1))
#define elist ((int*)(ws + WS_ELIST))
#define counts (F.ctl + CW_COUNTS)
#define cursor (F.ctl + CW_CURSOR)
    const int gw = F.vcu * NWAVES + F.wave, NGW = F.G * NWAVES, lane = F.lane;
    LAS unsigned char* ring = F.lds + RING_OFF;

    PH(0) {
        P0In I{args.in[1], args.in[2], args.in[3], args.in[5], args.in[6], args.in[20], args.in[23], args.in[25], args.in[26], args.in[27], args.in[28], args.in[29], args.in[30],
               args.in[12], args.in[13], args.in[14], args.in[15], args.in[16], args.in[17], args.in[18]};
        p0_prologue(F, I, ws, args.variant);
    }
    SEAM(0);
    PH(1) { if (gw < 96) { const int j = gw * 64 + lane; const float* mp = (const float*)(ws + WS_MODP); float s0 = mp[j], s1 = mp[6 * D_ + j];
#pragma unroll
            for (int q = 1; q < 16; ++q) { s0 += mp[(size_t)(q * 2) * 6 * D_ + j]; s1 += mp[(size_t)(q * 2 + 1) * 6 * D_ + j]; }
            mod[j] = s0; mod[6 * D_ + j] = s1; }
        norm_mod_rows<16>(F, x, args.in[4], (const float*)(ws + WS_MODP), 0, D_, XN); }
    SEAM(1);
    PH(2) { GridOrder S{(const char*)XN, (const char*)Win_t, 1024, 1024, 64, 8, 512, F.G, (int)blockIdx.x};
        EpiProj E{QKV, Ubuf, attn_body::C2};
        pg8::gemm_phase<EpiProj, GridOrder, false, true>(ring, 1024, 1024, 1024, S, E); }
    SEAM(2);
    PH(3) {
        const int xg = F.vcu >> 5, xl = F.vcu & 31;
        if (xl < 8) { const int sg = xg * 8 + xl;
            gu32* sbar = F.ctl + CW_SUB;
            { GroupOrder S{(const char*)Ubuf, (const char*)W2t, 384, 256, 128, 64, sg}; EpiSloc E{Sloc};
              pg8::gemm_phase<EpiSloc, GroupOrder, false, false>(ring, 256, 384, 256, S, E); }
            sub_barrier(F, sbar, 64u);
            { const int b = sg >> 5, g = sg & 31, p = lane, w = F.wave;
            const float lr = lamT[(g * 64 + p) * 2], li = lamT[(g * 64 + p) * 2 + 1];
            const size_t row0 = (size_t)g * 1024 + b * 512 + w * 64;
            pg8::f32x2 v[64];
            { const char* lp = (const char*)(Sloc + row0 * 128 + 2 * p);
#pragma unroll
              for (int j = 0; j < 64; ++j) { v[j] = *(const GAS pg8::f32x2*)(lp + (j & 7) * 512); if ((j & 7) == 7) { lp += 4096; asm volatile("" : "+v"(lp)); } } }
            float tr = 0.f, ti = 0.f;
#pragma unroll
            for (int j = 0; j < 64; ++j) { const float nr = lr * tr - li * ti + v[j].x, ni = lr * ti + li * tr + v[j].y; tr = nr; ti = ni; }
            LAS float* xs = (LAS float*)ring;
            xs[(w * 64 + p) * 2] = tr; xs[(w * 64 + p) * 2 + 1] = ti;
            float Lr = lr, Li = li;
#pragma unroll
            for (int q = 0; q < 6; ++q) { const float nr = Lr * Lr - Li * Li, ni = 2.f * Lr * Li; Lr = nr; Li = ni; }
            __syncthreads();
            float sr = 0.f, si = 0.f;
            for (int w2 = 0; w2 < w; ++w2) { const float xr = xs[(w2 * 64 + p) * 2], xi = xs[(w2 * 64 + p) * 2 + 1]; const float nr = Lr * sr - Li * si + xr, ni = Lr * si + Li * sr + xi; sr = nr; si = ni; }
            { char* sp = (char*)(Ubuf + row0 * 384 + 256 + 2 * p);
#pragma unroll
              for (int j = 0; j < 64; ++j) { *(GAS unsigned*)(sp + (j & 3) * 768) = pk2(sr, si); if ((j & 3) == 3) { sp += 3072; asm volatile("" : "+v"(sp)); }
                const float nr = lr * sr - li * si + v[j].x, ni = lr * si + li * sr + v[j].y; sr = nr; si = ni; } }
            __syncthreads();
        }
            sub_barrier(F, sbar, 128u);
            { GroupOrder S{(const char*)Ubuf, (const char*)W13t, 384, 384, 128, 64, sg}; EpiSsm2 E{Ubuf, args.in[19], Gb};
              pg8::gemm_phase<EpiSsm2, GroupOrder, false, false>(ring, 384, 384, 384, S, E); }
            sub_barrier(F, sbar, 192u);
            { GluOrder S{(const char*)Gb, (const char*)Wglu_t, sg}; EpiGlu E{Gb, args.in[21], concat};
              pg8::gemm_phase<EpiGlu, GluOrder, false, false>(ring, 512, 512, 512, S, E); }
        }
        const P0In I{args.in[1], args.in[2], args.in[3], args.in[5], args.in[6], args.in[20], args.in[23], args.in[25], args.in[26], args.in[27], args.in[28], args.in[29], args.in[30],
                     args.in[12], args.in[13], args.in[14], args.in[15], args.in[16], args.in[17], args.in[18]};
        if (xl >= 8 && xl < 8 + NCONV && !(args.variant & 256)) conv_queues(I, ws, F.ctl + CW_CQ, xg, lane);
        { const attn_body::AttnTensors AT{(const attn_body::bf16*)QKV, (attn_body::bf16*)Ob};
          const attn_body::QueueOrder S{F.ctl + CW_AQ + 64 * xg, (LAS int*)(F.lds + MISC_OFF + 64), xg};
          attn_body::attn_phase<attn_body::QueueOrder>((char*)lds + RING_OFF, AT, S); }
        if (!(args.variant & 256)) conv_queues(I, ws, F.ctl + CW_CQ, xg, lane);
    }
    SEAM(7);
    PH(8) {
        const float* lq1 = args.in[7]; const float* lk1 = args.in[8]; const float* lq2 = args.in[9]; const float* lk2 = args.in[10]; const float* subg = args.in[11];
        const float s1 = wave_sum(lq1[lane] * lk1[lane]), s2 = wave_sum(lq2[lane] * lk2[lane]);
        const float lam_init = 0.2f, lam = __expf(s1) - __expf(s2) + lam_init;
        const float g0 = subg[2 * lane] * (1.f - lam_init), g1 = subg[2 * lane + 1] * (1.f - lam_init);
        for (int m = gw; m < M_; m += NGW) {
            const GAS unsigned* orow = (const GAS unsigned*)(Ob + (size_t)m * 1024); GAS unsigned* crow = (GAS unsigned*)(concat + (size_t)m * 1024);
            unsigned a[4], b[4];
#pragma unroll
            for (int h = 0; h < 4; ++h) { a[h] = orow[h * 128 + lane]; b[h] = orow[h * 128 + 64 + lane]; }
#pragma unroll
            for (int h = 0; h < 4; ++h) { const float v0 = bflo(a[h]) - lam * bflo(b[h]), v1 = bfhi(a[h]) - lam * bfhi(b[h]);
                const float r = rsqrtf(wave_sum(v0 * v0 + v1 * v1) * (1.f / 128.f) + SUBLN_EPS);
                crow[h * 64 + lane] = pk2(v0 * r * g0, v1 * r * g1); }
        }
    }
    SEAM(8);
    PH(9) { GridOrder S{(const char*)concat, (const char*)Wout_t, 1024, 1024, 64, 4, 256, F.G, (int)blockIdx.x};
        EpiRes E{x, mod, X1};
        pg8::gemm_phase<EpiRes, GridOrder, false, false>(ring, 1024, 1024, 1024, S, E); }
    SEAM(9);
    PH(10) norm_mod_rows<1>(F, X1, args.in[22], mod, 3 * D_, 4 * D_, XN, ws + WS_XN8);
    SEAM(10);
    PH(11) { GridOrder S{(const char*)XN, (const char*)Wr_t, 1024, 1024, 64, 1, 64, F.G, (int)blockIdx.x};
        EpiLogits E{logits};
        pg8::gemm_phase<EpiLogits, GridOrder, false, false>(ring, 1024, 1024, 1024, S, E);
        if ((int)blockIdx.x >= 64) { const P0In I{args.in[1], args.in[2], args.in[3], args.in[5], args.in[6], args.in[20], args.in[23], args.in[25], args.in[26], args.in[27], args.in[28], args.in[29], args.in[30],
                         args.in[12], args.in[13], args.in[14], args.in[15], args.in[16], args.in[17], args.in[18]};
            conv8_range(I, ws, C8_P2, NB8, ((int)blockIdx.x - 64) * NWAVES + F.wave, (F.G - 64) * NWAVES, lane); } }
    SEAM(11);
#ifdef DBG_ROUTE
    PH(12) { for (int m = gw; m < M_; m += NGW) { nv::route_token<CSTR>(logits + (size_t)m * NE, args.in[24], lane, idx + m * 8, rw + m * 8, (unsigned*)counts);
            nv::route_token_dpp<CSTR, false>(logits + (size_t)m * NE, args.in[24], lane, slotpos + m * 8, (float*)sorted + m * 8, (unsigned*)counts);
            if (lane < DBG_ROUTE && slotpos[m * 8 + lane] != idx[m * 8 + lane]) atomicAdd((unsigned*)(F.ctl + 200000), 1u); } }
#else
    PH(12) { for (int m = gw; m < M_; m += NGW) { nv::route_token_dpp<CSTR>(logits + (size_t)m * NE, args.in[24], lane, idx + m * 8, rw + m * 8, (unsigned*)counts, slotpos + m * 8, elist, m);
            if (lane == 8) elist[NE * 16384 + m] = m; } }
#endif
    SEAM(12);
    PH(14) { const int ntot = build_expert_tables<2>(F, counts, 16);
        ExpertOrder8 S{(const LAS int*)(F.lds + TAB_OFFS), (const LAS int*)(F.lds + TAB_DESC), (const char*)(ws + WS_XN8), (const char*)(ws + WS_EGU), elist, F.G, F.vcu, ntot};
        EpiGateUp8 E{(unsigned char*)Hbuf};
        pg8::gemm_phase<EpiGateUp8, ExpertOrder8, true, true, true>(ring, 512, 512, 512, S, E); }
    SEAM(14);
    PH(15) { const int ntot = build_expert_tables<4>(F, counts, 32);
        ExpertOrderD8 S{(const LAS int*)(F.lds + TAB_OFFS), (const LAS int*)(F.lds + TAB_DESC), (const char*)Hbuf, (const char*)EDN, F.G, F.vcu, ntot};
        EpiDown8 E{(unsigned char*)Yb};
        int Kd = 128; asm volatile("" : "+s"(Kd));
        pg8::gemm_phase<EpiDown8, ExpertOrderD8, false, true, true>(ring, Kd, 128, 128, S, E); }
    SEAM(15);
    PH(16) {
        const float* fg = args.in[31]; const unsigned char* Y8 = (const unsigned char*)Yb;
        (void)build_expert_tables<1>(F, counts, 0);
        const LAS int* offs = (const LAS int*)(F.lds + TAB_OFFS);
        for (int m0 = gw * 8; m0 < M_; m0 += NGW * 8) {
            const int spv = offs[idx[m0 * 8 + lane]] + slotpos[m0 * 8 + lane]; const float wvv = rw[m0 * 8 + lane] * 0.0625f;
            const int b = m0 >> 13; const float* g2 = mod + b * 6 * D_ + 5 * D_;
            f32x4 gg2[4], fgg[4];
#pragma unroll
            for (int q4 = 0; q4 < 4; ++q4) { gg2[q4] = *(const GAS f32x4*)(g2 + 16 * lane + 4 * q4); fgg[q4] = *(const GAS f32x4*)(fg + 16 * lane + 4 * q4); }
#pragma unroll 2
            for (int t = 0; t < 8; ++t) { const int m = m0 + t;
                v4u yq[9]; float wk[9];
                yq[0] = *(const GAS v4u*)(Y8 + (size_t)(NSLOT + m) * 1024 + 16 * lane); wk[0] = 0.0625f;
#pragma unroll
                for (int k = 0; k < 8; ++k) { const int pos = __builtin_amdgcn_readlane(spv, t * 8 + k); wk[k + 1] = __int_as_float(__builtin_amdgcn_readlane(__float_as_int(wvv), t * 8 + k));
                    yq[k + 1] = *(const GAS v4u*)(Y8 + (size_t)pos * 1024 + 16 * lane); }
                f32x4 x1[4];
#pragma unroll
                for (int q4 = 0; q4 < 4; ++q4) x1[q4] = *(const GAS f32x4*)(X1 + (size_t)m * D_ + 16 * lane + 4 * q4);
                float accv[16];
#pragma unroll
                for (int i = 0; i < 16; ++i) accv[i] = 0.f;
#pragma unroll
                for (int k = 0; k < 9; ++k)
#pragma unroll
                    for (int d_ = 0; d_ < 4; ++d_) { const pg8::f32x2 lo_ = __builtin_amdgcn_cvt_pk_f32_fp8((int)yq[k][d_], false), hi_ = __builtin_amdgcn_cvt_pk_f32_fp8((int)yq[k][d_], true);
                        accv[4 * d_] += wk[k] * lo_[0]; accv[4 * d_ + 1] += wk[k] * lo_[1]; accv[4 * d_ + 2] += wk[k] * hi_[0]; accv[4 * d_ + 3] += wk[k] * hi_[1]; }
                float xv[16]; float s = 0.f;
#pragma unroll
                for (int q4 = 0; q4 < 4; ++q4)
#pragma unroll
                    for (int e = 0; e < 4; ++e) { const float v = x1[q4][e] + gg2[q4][e] * accv[q4 * 4 + e]; xv[q4 * 4 + e] = v; s += v * v; }
                const float rstd = rsqrtf(wave_sum(s) * (1.f / D_) + NORM_EPS);
#pragma unroll
                for (int q4 = 0; q4 < 4; ++q4) { f32x4 o; o.x = xv[q4 * 4 + 0] * rstd * fgg[q4].x; o.y = xv[q4 * 4 + 1] * rstd * fgg[q4].y; o.z = xv[q4 * 4 + 2] * rstd * fgg[q4].z; o.w = xv[q4 * 4 + 3] * rstd * fgg[q4].w;
                    *(GAS f32x4*)(out + (size_t)m * D_ + 16 * lane + 4 * q4) = o; }
            }
        }
    }
#undef IN
#undef SEAM
#undef mod
#undef lamT
#undef idx
#undef rw
#undef slotpos
#undef sorted
#undef logits
#undef Win_t
#undef Wout_t
#undef Wglu_t
#undef Wr_t
#undef W2t
#undef W13t
#undef EGU
#undef EDN
#undef XN
#undef QKV
#undef Ubuf
#undef Sloc
#undef Gb
#undef Ob
#undef concat
#undef Hbuf
#undef Yb
#undef X1
#undef elist
#undef counts
#undef cursor
}
}
#ifndef MK_PER_PHASE
#define MK_PER_PHASE 0
#endif
extern "C" void kernel_launch(void* const* d_in, const int* in_sizes, int n_in, void* d_out, int out_size, void* d_ws, size_t ws_size, hipStream_t stream) {
    using namespace mk;
    static int grid = 0;
    if (grid == 0) {
        if (n_in != 32 || in_sizes[0] != M_ * D_ || out_size != M_ * D_ || ws_size < WS_END) { fprintf(stderr, "kernel_launch: unexpected shapes (n_in %d, ws %zu < %zu?)\n", n_in, ws_size, (size_t)WS_END); grid = -1; return; }
        int dev = 0, cus = 0, per_cu = 0;
        if (hipGetDevice(&dev) != hipSuccess || hipDeviceGetAttribute(&cus, hipDeviceAttributeMultiprocessorCount, dev) != hipSuccess) { grid = -1; return; }
        if (hipFuncSetAttribute((const void*)mega_fwd, hipFuncAttributeMaxDynamicSharedMemorySize, LDS_BYTES) != hipSuccess) { fprintf(stderr, "kernel_launch: hipFuncSetAttribute failed\n"); grid = -1; return; }
        if (hipOccupancyMaxActiveBlocksPerMultiprocessor(&per_cu, (const void*)mega_fwd, NWAVES * 64, LDS_BYTES) != hipSuccess || per_cu < 1) { fprintf(stderr, "kernel_launch: occupancy query says %d blocks per CU\n", per_cu); (void)hipGetLastError(); grid = -1; return; }
        grid = cus;
        if (grid != 256) fprintf(stderr, "kernel_launch: note: %d CUs\n", grid);
    }
    if (grid < 0) return;
    (void)hipMemsetAsync((char*)d_ws + WS_CTL, 0, CTL_ZERO_BYTES, stream);
    Args a{};
    for (int i = 0; i < 32; ++i) a.in[i] = (const float*)d_in[i];
    a.out = (float*)d_out; a.ws = (unsigned char*)d_ws;
#if MK_PER_PHASE
    for (int k = 0; k < NPHASE; ++k) {
#ifdef EXP_F32_ROUTER
        if (k == 11) { float* XNf = (float*)((char*)d_ws + WS_QKV); float* modp = (float*)((char*)d_ws + WS_MOD); float* lg = (float*)((char*)d_ws + WS_LOGITS);
            nv::k_norm_mod<<<M_, 256, 0, stream>>>((const float*)d_out, (const float*)d_in[22], modp, 3 * D_, 4 * D_, XNf);
            nv::GemmArgs g{}; g.A = XNf; g.gather = nullptr; g.B = (const float*)d_in[23]; g.seg = nullptr; g.strideB = 0; g.lda = 1024; g.ldb = 256; g.M = M_; g.N = 256; g.K = 1024; g.pad = 0;
            nv::k_gemm<<<dim3(4, M_ / 64, 1), 256, 0, stream>>>(g, nv::EpiStore{lg, 256, 0});
            continue; }
#endif
        a.ph_lo = k; a.ph_hi = k + 1;
#ifndef HOST_REPEAT_MASK
#define HOST_REPEAT_MASK 0
#endif
#ifndef HOST_VARIANT
#define HOST_VARIANT 0
#endif
        for (int rep = 0; rep < 1 + ((HOST_REPEAT_MASK >> k) & 1); ++rep) { a.variant = (rep == 0 && ((HOST_REPEAT_MASK >> k) & 1)) ? HOST_VARIANT : 0; if (rep && k == 12) (void)hipMemsetAsync((char*)d_ws + CW_COUNTS * 4, 0, 256 * 64 * 4, stream); if (rep && k == 13) (void)hipMemsetAsync((char*)d_ws + CW_CURSOR * 4, 0, 256 * 64 * 4, stream); if (rep && k == 3) (void)hipMemsetAsync((char*)d_ws + CW_SUB * 4, 0, 64 * 40 * 4, stream);
            hipLaunchKernelGGL(mega_fwd, dim3(grid), dim3(NWAVES * 64), LDS_BYTES, stream, a); } }
#else
    a.ph_lo = 0; a.ph_hi = NPHASE;
    void* kargs[] = {&a};
    hipError_t e = hipLaunchCooperativeKernel((const void*)mega_fwd, dim3(grid), dim3(NWAVES * 64), kargs, LDS_BYTES, stream);
    if (e != hipSuccess) fprintf(stderr, "kernel_launch: cooperative launch failed: %s\n", hipGetErrorString(e));
#endif
}
```

```cpp
#include <hip/hip_runtime.h>
#include <hip/hip_bf16.h>
#include <cstdio>
#include <cstdint>
#include <cmath>
namespace nv {
template <int CS = 1> __device__ __forceinline__ void route_token(const float* lrow, const float* rbias, int lane, int* idx_out, float* w_out, unsigned* counts) {
    float v[4], s[4];
    { float4 lg = *(const float4*)(lrow + lane * 4); float4 rb = *(const float4*)(rbias + lane * 4);
      v[0] = 1.f / (1.f + __expf(-lg.x)); v[1] = 1.f / (1.f + __expf(-lg.y)); v[2] = 1.f / (1.f + __expf(-lg.z)); v[3] = 1.f / (1.f + __expf(-lg.w));
      s[0] = v[0] + rb.x; s[1] = v[1] + rb.y; s[2] = v[2] + rb.z; s[3] = v[3] + rb.w; }
    float m1 = fmaxf(s[0], s[1]), m2 = fminf(s[0], s[1]);
    { float a = fmaxf(s[2], s[3]), bb = fminf(s[2], s[3]); float n1 = fmaxf(m1, a); float n2 = fmaxf(fminf(m1, a), fmaxf(m2, bb)); m1 = n1; m2 = n2; }
#pragma unroll
    for (int o = 1; o < 8; o <<= 1) { float a1 = __shfl_xor(m1, o), a2 = __shfl_xor(m2, o); float n1 = fmaxf(m1, a1); float n2 = fmaxf(fminf(m1, a1), fmaxf(m2, a2)); m1 = n1; m2 = n2; }
    const float gs = m1 + m2; const int mygrp = lane >> 3;
    int rank = 0;
#pragma unroll
    for (int gq = 0; gq < 8; ++gq) { float og = __shfl(gs, gq * 8); rank += (og > gs || (og == gs && gq < mygrp)) ? 1 : 0; }
    const bool sel = rank < 4;
#pragma unroll
    for (int i = 0; i < 4; ++i) if (!sel) s[i] = -INFINITY;
    float wsum = 0.f; float myw = 0.f; int myidx = 0;
#pragma unroll
    for (int k = 0; k < 8; ++k) {
        float bv = s[0]; int bi = 0;
#pragma unroll
        for (int i = 1; i < 4; ++i) if (s[i] > bv) { bv = s[i]; bi = i; }
        int be = lane * 4 + bi;
#pragma unroll
        for (int o = 1; o < 64; o <<= 1) { float ov = __shfl_xor(bv, o); int oe = __shfl_xor(be, o); if (ov > bv || (ov == bv && oe < be)) { bv = ov; be = oe; } }
        const int wl = be >> 2, wi = be & 3;
        float vsel = (wi == 0) ? v[0] : (wi == 1) ? v[1] : (wi == 2) ? v[2] : v[3];
        vsel = __shfl(vsel, wl);
        if (lane == wl) { if (wi == 0) s[0] = -INFINITY; else if (wi == 1) s[1] = -INFINITY; else if (wi == 2) s[2] = -INFINITY; else s[3] = -INFINITY; }
        wsum += vsel; if (lane == k) { myw = vsel; myidx = be; }
    }
    if (lane < 8) { idx_out[lane] = myidx; w_out[lane] = myw / wsum * 2.5f; atomicAdd(&counts[myidx * CS], 1u); }
}
__device__ __forceinline__ unsigned umax_(unsigned a, unsigned b) { return a > b ? a : b; }
__device__ __forceinline__ unsigned wave_umax_dpp(unsigned k) {
#ifdef EXP_SHFL_MAX
    for (int o = 1; o < 64; o <<= 1) k = umax_(k, (unsigned)__shfl_xor((int)k, o));
    return (unsigned)__builtin_amdgcn_readfirstlane((int)k);
#endif
    k = umax_(k, (unsigned)__builtin_amdgcn_update_dpp(0, (int)k, 0x111, 0xf, 0xf, false));
    k = umax_(k, (unsigned)__builtin_amdgcn_update_dpp(0, (int)k, 0x112, 0xf, 0xf, false));
    k = umax_(k, (unsigned)__builtin_amdgcn_update_dpp(0, (int)k, 0x114, 0xf, 0xf, false));
    k = umax_(k, (unsigned)__builtin_amdgcn_update_dpp(0, (int)k, 0x118, 0xf, 0xf, false));
    k = umax_(k, (unsigned)__builtin_amdgcn_update_dpp(0, (int)k, 0x142, 0xa, 0xf, false));
    k = umax_(k, (unsigned)__builtin_amdgcn_update_dpp(0, (int)k, 0x143, 0xc, 0xf, false));
    return (unsigned)__builtin_amdgcn_readlane((int)k, 63);
}
__device__ __forceinline__ unsigned fkey(float f) { const unsigned u = __float_as_uint(f); return u ^ ((u >> 31) ? 0xffffffffu : 0x80000000u); }
template <int CS, bool COUNT = true> __device__ __forceinline__ void route_token_dpp(const float* lrow, const float* rbias, int lane, int* idx_out, float* w_out, unsigned* counts, int* rank_out = nullptr, int* list_out = nullptr, int token = 0) {
    float v[4], s[4];
    { const float4 lg = *(const float4*)(lrow + lane * 4); const float4 rb = *(const float4*)(rbias + lane * 4);
      v[0] = 1.f / (1.f + __expf(-lg.x)); v[1] = 1.f / (1.f + __expf(-lg.y)); v[2] = 1.f / (1.f + __expf(-lg.z)); v[3] = 1.f / (1.f + __expf(-lg.w));
      s[0] = v[0] + rb.x; s[1] = v[1] + rb.y; s[2] = v[2] + rb.z; s[3] = v[3] + rb.w; }
    float m1 = fmaxf(s[0], s[1]), m2 = fminf(s[0], s[1]);
    { const float a = fmaxf(s[2], s[3]), bb = fminf(s[2], s[3]); const float n1 = fmaxf(m1, a), n2 = fmaxf(fminf(m1, a), fmaxf(m2, bb)); m1 = n1; m2 = n2; }
#pragma unroll
    for (int o = 1; o < 8; o <<= 1) { const float a1 = __shfl_xor(m1, o), a2 = __shfl_xor(m2, o); const float n1 = fmaxf(m1, a1), n2 = fmaxf(fminf(m1, a1), fmaxf(m2, a2)); m1 = n1; m2 = n2; }
    const float gs = m1 + m2; const int mygrp = lane >> 3; int rank = 0;
#pragma unroll
    for (int gq = 0; gq < 8; ++gq) { const float og = __int_as_float(__builtin_amdgcn_readlane(__float_as_int(gs), gq * 8)); rank += (og > gs || (og == gs && gq < mygrp)) ? 1 : 0; }
    unsigned key[4];
#pragma unroll
    for (int i = 0; i < 4; ++i) key[i] = (rank < 4) ? fkey(s[i]) : 0u;
    float wsum = 0.f, myw = 0.f; int myidx = 0;
#pragma unroll
    for (int k = 0; k < 8; ++k) {
        unsigned bk = key[0]; int bi = 0;
#pragma unroll
        for (int i = 1; i < 4; ++i) if (key[i] > bk) { bk = key[i]; bi = i; }
        const unsigned mk = wave_umax_dpp(bk);
        const unsigned long long bal = __ballot(bk == mk);
        const int wl = __builtin_amdgcn_readfirstlane((int)__builtin_ctzll(bal));
        const int wi = __builtin_amdgcn_readlane(bi, wl);
        const float vsel0 = (wi == 0) ? v[0] : (wi == 1) ? v[1] : (wi == 2) ? v[2] : v[3];
        const float vsel = __int_as_float(__builtin_amdgcn_readlane(__float_as_int(vsel0), wl));
        { const bool me = (lane == wl);
#pragma unroll
          for (int i = 0; i < 4; ++i) key[i] = (me && wi == i) ? 0u : key[i]; }
        wsum += vsel; if (lane == k) { myw = vsel; myidx = wl * 4 + wi; }
    }
    if (lane < 8) { idx_out[lane] = myidx; w_out[lane] = myw / wsum * 2.5f; if (COUNT) { const unsigned rk = atomicAdd(&counts[myidx * CS], 1u); if (rank_out) rank_out[lane] = (int)rk; if (list_out) list_out[myidx * 16384 + (int)rk] = token; } }
}
}
namespace pg8 {
#define PG8_LAS __attribute__((address_space(3)))
typedef unsigned short bf16_t;
typedef short bf16x8 __attribute__((ext_vector_type(8)));
typedef float f32x4 __attribute__((ext_vector_type(4)));
typedef float f32x2 __attribute__((ext_vector_type(2)));
typedef unsigned u32x4 __attribute__((ext_vector_type(4)));
typedef unsigned u32x2 __attribute__((ext_vector_type(2)));
constexpr int BM = 256, BK = 64, HALF = 128, HTB = HALF * BK * 2  , STAGE_BYTES = 8 * HTB;

__host__ __device__ __forceinline__ int lds_x(int r, int k) { return r * 128 + ((((k >> 3) ^ r) & 7) << 4) + (k & 7) * 2; }
__host__ __device__ __forceinline__ int lds_byte(int r, int c) { const int st = (r >> 4) * 2 + (c >> 5), rr = r & 15, cc = c & 31, ob = rr * 64 + cc * 2; return st * 1024 + (ob ^ (((ob >> 9) & 1) << 5)); }
__host__ __device__ __forceinline__ void stage_rc(int b, int& R, int& C) { const int st = b / 1024, sb = b % 1024, swz = sb ^ (((sb >> 9) & 1) << 5); R = (st >> 1) * 16 + swz / 64; C = (st & 1) * 32 + (swz % 64) / 2; }
__host__ __device__ __forceinline__ int perm32(int rho) { const int n = rho >> 4, i = rho & 15; return 8 * (i >> 2) + 4 * n + (i & 3); }

struct Unit { const char* A; const char* B; const int* gath; int pm, pn, r0, nv; };

__device__ __forceinline__ unsigned cvt_pk_bf16(float lo, float hi) { unsigned r; asm volatile("v_cvt_pk_bf16_f32 %0, %1, %2" : "=v"(r) : "v"(lo), "v"(hi)); return r; }

template <class E, class = void> struct has_p16 { static constexpr bool v = false; };
template <class E> struct has_p16<E, decltype((void)E::PERM16)> { static constexpr bool v = E::PERM16; };
template <class Epi, class Sched, bool GATHER, bool ALIGN_EPI, bool FP8 = false>
__device__ __forceinline__ void gemm_phase(PG8_LAS unsigned char* lds, const int K, const int lda, const int ldb, const Sched& S, const Epi& E) {
    int tid_ = threadIdx.x; asm volatile("" : "+v"(tid_));
    const int tid = tid_, wid = __builtin_amdgcn_readfirstlane(tid >> 6), lane = tid & 63, wr = wid >> 2, wc = wid & 3, fr = lane & 15, fq = lane >> 4;
    const int nt = K / BK;
    unsigned voffA[2][2], voffB[2];
#pragma unroll
    for (int i = 0; i < 2; ++i) { const int R = 8 * wid + 64 * i + (lane >> 3), C = 8 * ((lane ^ (lane >> 3)) & 7); const int Rb = has_p16<Epi>::v ? (64 * (R >> 5) + 16 * ((R & 15) >> 2) + 4 * ((R >> 4) & 1) + (R & 3)) : Epi::PERM ? ((R & ~31) + perm32(R & 31)) : R;
        voffA[0][i] = (unsigned)(R * lda + C) * 2u; voffA[1][i] = (unsigned)((R + HALF) * lda + C) * 2u; voffB[i] = (unsigned)(Rb * ldb + C) * 2u; }
    const size_t kstep = (size_t)(BK * 2);
    const size_t hstepB = (size_t)(has_p16<Epi>::v ? 8 : HALF) * ldb * 2;
    const unsigned ldsw = (unsigned)wid * 1024u;
    const int aoff0 = lds_x(wr * 64 + fr, fq * 8), aoff1 = aoff0 ^ 64, boff0 = lds_x(wc * 32 + fr, fq * 8), boff1 = boff0 ^ 64;
#define PG8_SA(b, h) (((b) * 2 + (h)) * HTB)
#define PG8_SB(b, h) ((4 + (b) * 2 + (h)) * HTB)
#define PG8_STAGE(bufoff, gbase, voff) do { _Pragma("unroll") for (int _i = 0; _i < 2; ++_i) \
        __builtin_amdgcn_global_load_lds((const unsigned*)((const char*)(gbase) + (voff)[_i]), (PG8_LAS unsigned*)(lds + (bufoff) + ldsw + _i * 8192), 16, 0, 0); } while (0)
#define PG8_LDA(dst, b, h) do { _Pragma("unroll") for (int m = 0; m < 4; ++m) _Pragma("unroll") for (int k = 0; k < 2; ++k) dst[m][k] = *(const PG8_LAS bf16x8*)(lds + PG8_SA(b, h) + (k ? aoff1 : aoff0) + m * 2048); } while (0)
#define PG8_LDB(dst, b, h) do { _Pragma("unroll") for (int n = 0; n < 2; ++n) _Pragma("unroll") for (int k = 0; k < 2; ++k) dst[n][k] = *(const PG8_LAS bf16x8*)(lds + PG8_SB(b, h) + (k ? boff1 : boff0) + n * 2048); } while (0)
#define PG8_MMA(ai, bj, At, Bt) do { __builtin_amdgcn_s_setprio(1); _Pragma("unroll") for (int m = 0; m < 4; ++m) _Pragma("unroll") for (int n = 0; n < 2; ++n) _Pragma("unroll") for (int k = 0; k < 2; ++k) { \
        if constexpr (FP8) { typedef long l2_ __attribute__((ext_vector_type(2))); const l2_ b_ = __builtin_bit_cast(l2_, Bt[n][k]), a_ = __builtin_bit_cast(l2_, At[m][k]);     \
            acc[ai][bj][m][n] = __builtin_amdgcn_mfma_f32_16x16x32_fp8_fp8(b_.x, a_.x, acc[ai][bj][m][n], 0, 0, 0); acc[ai][bj][m][n] = __builtin_amdgcn_mfma_f32_16x16x32_fp8_fp8(b_.y, a_.y, acc[ai][bj][m][n], 0, 0, 0); } \
        else acc[ai][bj][m][n] = __builtin_amdgcn_mfma_f32_16x16x32_bf16(Bt[n][k], At[m][k], acc[ai][bj][m][n], 0, 0, 0); } __builtin_amdgcn_s_setprio(0); } while (0)
#define PG8_WAIT_V(n) asm volatile("s_waitcnt vmcnt(" #n ")" ::: "memory")
#define PG8_WAIT_L(n) asm volatile("s_waitcnt lgkmcnt(" #n ")" ::: "memory")
#define PG8_BAR __builtin_amdgcn_s_barrier()
#define PG8_SCHED __builtin_amdgcn_sched_barrier(0)
#define PG8_GATH(gp) do { if constexpr (GATHER) { _Pragma("unroll") for (int _i = 0; _i < 2; ++_i) { const int R_ = 8 * wid + 64 * _i + (lane >> 3), C_ = 8 * ((lane ^ (lane >> 3)) & 7); \
        voffA[0][_i] = (unsigned)(((gp)[R_] & 16383) * lda + C_) * 2u; voffA[1][_i] = (unsigned)(((gp)[R_ + HALF] & 16383) * lda + C_) * 2u; } } } while (0)
    Unit cur, nxt; int ui = 0;
    if (!S.next(0, cur)) return;
    f32x4 acc[2][2][4][2];
#pragma unroll
    for (int a = 0; a < 2; ++a)
#pragma unroll
        for (int b = 0; b < 2; ++b)
#pragma unroll
            for (int m = 0; m < 4; ++m)
#pragma unroll
                for (int n = 0; n < 2; ++n) acc[a][b][m][n] = (f32x4){0.f, 0.f, 0.f, 0.f};
    bf16x8 At[4][2], B0[2][2], B1[2][2];
    const char* cA = cur.A; const char* cB = cur.B;
    PG8_GATH(cur.gath);
    PG8_STAGE(PG8_SB(0, 0), cB, voffB); PG8_STAGE(PG8_SB(0, 1), cB + hstepB, voffB); PG8_STAGE(PG8_SA(0, 0), cA, voffA[0]); PG8_STAGE(PG8_SA(0, 1), cA, voffA[1]);
    if (wr == 1) PG8_BAR;
    PG8_WAIT_V(2); PG8_BAR;
    PG8_STAGE(PG8_SB(1, 0), cB + kstep, voffB); PG8_STAGE(PG8_SA(1, 0), cA + kstep, voffA[0]); PG8_STAGE(PG8_SB(1, 1), cB + hstepB + kstep, voffB);
    PG8_WAIT_V(6); PG8_BAR;
    for (;;) {
        const bool has_next = S.next(ui + 1, nxt);
        const char* nA = has_next ? nxt.A : cA; const char* nB = has_next ? nxt.B : cB;
#pragma unroll 1
        for (int t = 0; t < nt; t += 2) {
            const bool last = (t == nt - 2);
            const char* a1 = cA + (size_t)(t + 1) * kstep;
            const char* a2 = last ? nA : cA + (size_t)(t + 2) * kstep; const char* b2 = last ? nB : cB + (size_t)(t + 2) * kstep;
            const char* a3 = a2 + kstep; const char* b3 = b2 + kstep;
            PG8_LDB(B0, 0, 0); PG8_LDB(B1, 0, 1); PG8_SCHED; PG8_LDA(At, 0, 0); PG8_STAGE(PG8_SA(1, 1), a1, voffA[1]);
            if constexpr (GATHER) { if (last && has_next) { PG8_GATH(nxt.gath); } }
            PG8_WAIT_V(8); PG8_WAIT_L(0); PG8_BAR; PG8_MMA(0, 0, At, B0); PG8_MMA(0, 1, At, B1); PG8_BAR; PG8_SCHED;
            PG8_LDA(At, 0, 1); PG8_STAGE(PG8_SB(0, 0), b2, voffB); PG8_STAGE(PG8_SB(0, 1), b2 + hstepB, voffB); PG8_STAGE(PG8_SA(0, 0), a2, voffA[0]);
            PG8_WAIT_V(8); PG8_WAIT_L(0); PG8_BAR; PG8_MMA(1, 0, At, B0); PG8_MMA(1, 1, At, B1); PG8_BAR; PG8_SCHED;
            PG8_LDB(B0, 1, 0); PG8_LDB(B1, 1, 1); PG8_SCHED; PG8_LDA(At, 1, 0); PG8_STAGE(PG8_SA(0, 1), a2, voffA[1]);
            PG8_WAIT_V(8); PG8_WAIT_L(0); PG8_BAR; PG8_MMA(0, 0, At, B0); PG8_MMA(0, 1, At, B1); PG8_BAR; PG8_SCHED;
            PG8_LDA(At, 1, 1); PG8_STAGE(PG8_SB(1, 0), b3, voffB); PG8_STAGE(PG8_SB(1, 1), b3 + hstepB, voffB); PG8_STAGE(PG8_SA(1, 0), a3, voffA[0]);
            PG8_WAIT_V(8); PG8_WAIT_L(0); PG8_BAR; PG8_MMA(1, 0, At, B0); PG8_MMA(1, 1, At, B1); PG8_BAR; PG8_SCHED;
        }
        if constexpr (ALIGN_EPI) { if (wr == 0) PG8_BAR; }
        E(acc, cur, wr, wc, fr, fq);
        if (!has_next) break;
#pragma unroll
        for (int a = 0; a < 2; ++a)
#pragma unroll
            for (int b = 0; b < 2; ++b)
#pragma unroll
                for (int m = 0; m < 4; ++m)
#pragma unroll
                    for (int n = 0; n < 2; ++n) acc[a][b][m][n] = (f32x4){0.f, 0.f, 0.f, 0.f};
        cur = nxt; cA = nA; cB = nB; ++ui;
        if constexpr (ALIGN_EPI) { if (wr == 1) PG8_BAR; }
    }
    PG8_WAIT_V(0);
    if constexpr (!ALIGN_EPI) { if (wr == 0) PG8_BAR; }
    PG8_BAR;
#undef PG8_SA
#undef PG8_SB
#undef PG8_STAGE
#undef PG8_LDA
#undef PG8_LDB
#undef PG8_MMA
#undef PG8_WAIT_V
#undef PG8_WAIT_L
#undef PG8_BAR
#undef PG8_SCHED
#undef PG8_GATH
}
}
namespace mg {
using pg8::bf16x8; using pg8::f32x4; using pg8::u32x4; using pg8::u32x2; using pg8::lds_byte; using pg8::stage_rc; using pg8::perm32; using pg8::cvt_pk_bf16;
#define MG_LAS __attribute__((address_space(3)))
#define MG_GAS __attribute__((address_space(1)))
constexpr int HTB = 16384;
__device__ __forceinline__ int lds_x(int r, int k) { return r * 128 + ((((k >> 3) ^ r) & 7) << 4) + (k & 7) * 2; }
constexpr int LDS_A = 0, LDS_B = 6 * HTB, STAGE_BYTES = 8 * HTB;
struct Unit { const char* A; const float* B0; const float* B1; const int* gath; int pm, pn, r0, nv; };

struct BMapPerm {
    static __device__ __forceinline__ const float* src(const Unit& u, int R4) { return u.B0 + (R4 & ~31) + perm32(R4 & 31); } };
struct BMapGateUp {
    static __device__ __forceinline__ const float* src(const Unit& u, int R4) { const int blk = R4 >> 4; return ((blk & 1) ? u.B1 : u.B0) + (blk >> 1) * 16 + (R4 & 15); } };

template <class Epi, class Sched, class BMap, bool GATHER>
__device__ __forceinline__ void gemm_phase(MG_LAS unsigned char* lds, const int K, const int lda, const int ldw, const Sched& S, const Epi& E) {
    int tid_ = threadIdx.x; asm volatile("" : "+v"(tid_));
    const int tid = tid_, wid = __builtin_amdgcn_readfirstlane(tid >> 6), lane = tid & 63, wr = wid >> 2, wc = wid & 3, fr = lane & 15, fq = lane >> 4;
    const int nt = K / 64;
    unsigned voffA[2][2];
#pragma unroll
    for (int i = 0; i < 2; ++i) { const int R = 8 * wid + 64 * i + (lane >> 3), C = 8 * ((lane ^ (lane >> 3)) & 7); voffA[0][i] = (unsigned)(R * lda + C) * 2u; voffA[1][i] = (unsigned)((R + 128) * lda + C) * 2u; }
    const unsigned ldsw = (unsigned)wid * 1024u;
    const int aoff0 = lds_x(wr * 64 + fr, fq * 8), aoff1 = aoff0 ^ 64, boff0 = lds_x(wc * 32 + fr, fq * 8), boff1 = boff0 ^ 64;
    const int kh = lane & 1, kc = ((lane >> 1) & 3) | ((wid & 1) << 2), ng = ((lane >> 3) & 7) | ((wid >> 1) << 3);
    const int brow = 8 * kc + 4 * kh;
    unsigned bwr[4];
#pragma unroll
    for (int i = 0; i < 4; ++i) bwr[i] = (unsigned)lds_x(4 * ng + i, brow);
    const size_t kstepA = 128, kstepB = (size_t)64 * ldw;
#define MG_SA(s, h) (LDS_A + ((s) * 2 + (h)) * HTB)
#define MG_SB(b) (LDS_B + (b) * HTB)
#define MG_DMA_A(slot, base) do { _Pragma("unroll") for (int _h = 0; _h < 2; ++_h) _Pragma("unroll") for (int _i = 0; _i < 2; ++_i) \
        __builtin_amdgcn_global_load_lds((const unsigned*)((base) + voffA[_h][_i]), (MG_LAS unsigned*)(lds + MG_SA(slot, _h) + ldsw + _i * 8192), 16, 0, 0); } while (0)
#define MG_LDA(dst, slot, h) do { _Pragma("unroll") for (int m = 0; m < 4; ++m) _Pragma("unroll") for (int k = 0; k < 2; ++k) dst[m][k] = *(const MG_LAS bf16x8*)(lds + MG_SA(slot, h) + (k ? aoff1 : aoff0) + m * 2048); } while (0)
#define MG_LDB(dst, b) do { _Pragma("unroll") for (int n = 0; n < 2; ++n) _Pragma("unroll") for (int k = 0; k < 2; ++k) dst[n][k] = *(const MG_LAS bf16x8*)(lds + MG_SB(b) + (k ? boff1 : boff0) + n * 2048); } while (0)
#define MG_BLOAD(set, p) do { const float* _p = (p); \
        asm volatile("global_load_dwordx4 %0, %1, off" : "=v"(set[0]) : "v"(_p) : "memory"); \
        asm volatile("global_load_dwordx4 %0, %1, off" : "=v"(set[1]) : "v"(_p + (size_t)ldw) : "memory"); \
        asm volatile("global_load_dwordx4 %0, %1, off" : "=v"(set[2]) : "v"(_p + (size_t)2 * ldw) : "memory"); \
        asm volatile("global_load_dwordx4 %0, %1, off" : "=v"(set[3]) : "v"(_p + (size_t)3 * ldw) : "memory"); } while (0)
#define MG_WAIT_B(set) asm volatile("s_waitcnt vmcnt(8)" : "+v"(set[0]), "+v"(set[1]), "+v"(set[2]), "+v"(set[3]) :: "memory")
#define MG_BWRITE(set, b) do { _Pragma("unroll") for (int _i = 0; _i < 4; ++_i) { u32x2 _w; _w.x = cvt_pk_bf16(set[0][_i], set[1][_i]); _w.y = cvt_pk_bf16(set[2][_i], set[3][_i]); \
        *(MG_LAS u32x2*)(lds + MG_SB(b) + bwr[_i]) = _w; } } while (0)
#define MG_MMA(ai, At) do { _Pragma("unroll") for (int m = 0; m < 4; ++m) _Pragma("unroll") for (int n = 0; n < 2; ++n) _Pragma("unroll") for (int k = 0; k < 2; ++k) \
        acc[ai][m][n] = __builtin_amdgcn_mfma_f32_16x16x32_bf16(Bf[n][k], At[m][k], acc[ai][m][n], 0, 0, 0); } while (0)
#define MG_WAIT_V(n) asm volatile("s_waitcnt vmcnt(" #n ")" ::: "memory")
#define MG_WAIT_L(n) asm volatile("s_waitcnt lgkmcnt(" #n ")" ::: "memory")
#define MG_BAR __builtin_amdgcn_s_barrier()
#define MG_SCHED __builtin_amdgcn_sched_barrier(0)
#define MG_GATH(gp) do { if constexpr (GATHER) { _Pragma("unroll") for (int _i = 0; _i < 2; ++_i) { const int R_ = 8 * wid + 64 * _i + (lane >> 3), C_ = 8 * ((lane ^ (lane >> 3)) & 7); \
        voffA[0][_i] = (unsigned)((gp)[R_] * lda + C_) * 2u; voffA[1][_i] = (unsigned)((gp)[R_ + 128] * lda + C_) * 2u; } } } while (0)
    Unit cu, au, bu; int ia = 0, ib = 0, ic = 0;
    if (!S.next(0, cu)) return;
    au = cu; bu = cu;
    const char* pa = au.A; int ta = 0; bool aend = false;
    const float* pb = BMap::src(bu, 4 * ng) + (size_t)brow * ldw; int tb = 0; bool bend = false;
    MG_GATH(au.gath);
#define MG_ADV_A() do { ++ta; pa += kstepA; if (ta == nt) { Unit nu_; if (!aend && S.next(ia + 1, nu_)) { ++ia; au = nu_; pa = au.A; ta = 0; MG_GATH(au.gath); } else { aend = true; ta = nt - 1; pa -= kstepA; } } } while (0)
#define MG_ADV_B() do { ++tb; pb += kstepB; if (tb == nt) { Unit nu_; if (!bend && S.next(ib + 1, nu_)) { ++ib; bu = nu_; pb = BMap::src(bu, 4 * ng) + (size_t)brow * ldw; tb = 0; } else { bend = true; tb = nt - 1; pb -= kstepB; } } } while (0)
    f32x4 acc[2][4][2];
#pragma unroll
    for (int a = 0; a < 2; ++a)
#pragma unroll
        for (int m = 0; m < 4; ++m)
#pragma unroll
            for (int n = 0; n < 2; ++n) acc[a][m][n] = (f32x4){0.f, 0.f, 0.f, 0.f};
    bf16x8 At0[4][2], At1[4][2], Bf[2][2];
    f32x4 Bx[4], By[4];
    MG_BLOAD(Bx, pb); MG_ADV_B();
    MG_DMA_A(0, pa); MG_ADV_A();
    MG_BLOAD(By, pb); MG_ADV_B();
    MG_DMA_A(1, pa); MG_ADV_A();
    MG_WAIT_B(Bx);
    MG_BWRITE(Bx, 0);
    MG_BLOAD(Bx, pb); MG_ADV_B();
    MG_WAIT_L(0); MG_BAR;
    if (wr == 1) MG_BAR;
    int slot = 0;
#define MG_STEP(Bnext, bcur, bnext) do { \
        const int s2_ = (slot == 0) ? 2 : slot - 1;                        \
        MG_LDB(Bf, bcur); MG_SCHED; MG_LDA(At0, slot, 0); MG_LDA(At1, slot, 1); \
        MG_DMA_A(s2_, pa); MG_ADV_A(); \
        MG_WAIT_B(Bnext); \
        MG_BWRITE(Bnext, bnext); \
        MG_BLOAD(Bnext, pb); MG_ADV_B(); \
        MG_WAIT_L(0); MG_BAR; \
        __builtin_amdgcn_s_setprio(1); MG_MMA(0, At0); if (cu.nv > 128) { MG_MMA(1, At1); } __builtin_amdgcn_s_setprio(0); \
        MG_BAR; MG_SCHED; \
        slot = (slot == 2) ? 0 : slot + 1; } while (0)
    for (;;) {
#pragma unroll 1
        for (int t = 0; t < nt; t += 2) { MG_STEP(By, 0, 1); MG_STEP(Bx, 1, 0); }
        E(acc, cu, wr, wc, fr, fq);
        Unit nu;
        if (!S.next(ic + 1, nu)) break;
        ++ic; cu = nu;
#pragma unroll
        for (int a = 0; a < 2; ++a)
#pragma unroll
            for (int m = 0; m < 4; ++m)
#pragma unroll
                for (int n = 0; n < 2; ++n) acc[a][m][n] = (f32x4){0.f, 0.f, 0.f, 0.f};
    }
    MG_WAIT_V(0);
    if (wr == 0) MG_BAR;
    MG_BAR;
#undef MG_SA
#undef MG_SB
#undef MG_DMA_A
#undef MG_LDA
#undef MG_LDB
#undef MG_BLOAD
#undef MG_WAIT_B
#undef MG_BWRITE
#undef MG_MMA
#undef MG_WAIT_V
#undef MG_WAIT_L
#undef MG_BAR
#undef MG_SCHED
#undef MG_GATH
#undef MG_ADV_A
#undef MG_ADV_B
#undef MG_STEP
}
template <class Epi, class Sched, class BMap, bool GATHER>
__device__ __forceinline__ void gemm_phase8(MG_LAS unsigned char* lds, const int K, const int lda, const int ldw, const Sched& S, const Epi& E) {
    int tid_ = threadIdx.x; asm volatile("" : "+v"(tid_));
    const int tid = tid_, wid = __builtin_amdgcn_readfirstlane(tid >> 6), lane = tid & 63, wr = wid >> 2, wc = wid & 3, fr = lane & 15, fq = lane >> 4;
    const int nt = K / 128;
    unsigned voffA[2][2];
#pragma unroll
    for (int i = 0; i < 2; ++i) { const int R = 8 * wid + 64 * i + (lane >> 3), C = 8 * ((lane ^ (lane >> 3)) & 7); voffA[0][i] = (unsigned)(R * lda + C) * 2u; voffA[1][i] = (unsigned)((R + 128) * lda + C) * 2u; }
    const unsigned ldsw = (unsigned)wid * 1024u;
    const int aoff0 = lds_x(wr * 64 + fr, fq * 8), aoff1 = aoff0 ^ 64, boff0 = lds_x(wc * 32 + fr, fq * 8), boff1 = boff0 ^ 64;
    const int kh = lane & 1, kc = ((lane >> 1) & 3) | ((wid & 1) << 2), ng = ((lane >> 3) & 7) | ((wid >> 1) << 3);
    const int brow = 16 * kc + 8 * kh;
    unsigned bwr[4];
#pragma unroll
    for (int i = 0; i < 4; ++i) bwr[i] = (unsigned)lds_x(4 * ng + i, 8 * kc + 4 * kh);
    const size_t kstepA = 128, kstepB = (size_t)128 * ldw;
#define MG_SA(s, h) (LDS_A + ((s) * 2 + (h)) * HTB)
#define MG_SB(b) (LDS_B + (b) * HTB)
#define MG_DMA_A(slot, base) do { _Pragma("unroll") for (int _h = 0; _h < 2; ++_h) _Pragma("unroll") for (int _i = 0; _i < 2; ++_i) \
        __builtin_amdgcn_global_load_lds((const unsigned*)((base) + voffA[_h][_i]), (MG_LAS unsigned*)(lds + MG_SA(slot, _h) + ldsw + _i * 8192), 16, 0, 0); } while (0)
#define MG_LDA(dst, slot, h) do { _Pragma("unroll") for (int m = 0; m < 4; ++m) _Pragma("unroll") for (int k = 0; k < 2; ++k) dst[m][k] = *(const MG_LAS bf16x8*)(lds + MG_SA(slot, h) + (k ? aoff1 : aoff0) + m * 2048); } while (0)
#define MG_LDB(dst, b) do { _Pragma("unroll") for (int n = 0; n < 2; ++n) _Pragma("unroll") for (int k = 0; k < 2; ++k) dst[n][k] = *(const MG_LAS bf16x8*)(lds + MG_SB(b) + (k ? boff1 : boff0) + n * 2048); } while (0)
#define MG_BLOAD(set, p) do { const float* _p = (p); _Pragma("unroll") for (int _j = 0; _j < 8; ++_j) \
        asm volatile("global_load_dwordx4 %0, %1, off" : "=v"(set[_j]) : "v"(_p + (size_t)_j * ldw) : "memory"); } while (0)
#define MG_WAIT_B(set) asm volatile("s_waitcnt vmcnt(4)" : "+v"(set[0]), "+v"(set[1]), "+v"(set[2]), "+v"(set[3]), "+v"(set[4]), "+v"(set[5]), "+v"(set[6]), "+v"(set[7]) :: "memory")
#define MG_BWRITE(set, b) do { _Pragma("unroll") for (int _i = 0; _i < 4; ++_i) { u32x2 _w; \
        int _a = __builtin_amdgcn_cvt_pk_fp8_f32(set[0][_i] * 64.f, set[1][_i] * 64.f, 0, false); _a = __builtin_amdgcn_cvt_pk_fp8_f32(set[2][_i] * 64.f, set[3][_i] * 64.f, _a, true); \
        int _b = __builtin_amdgcn_cvt_pk_fp8_f32(set[4][_i] * 64.f, set[5][_i] * 64.f, 0, false); _b = __builtin_amdgcn_cvt_pk_fp8_f32(set[6][_i] * 64.f, set[7][_i] * 64.f, _b, true); \
        _w.x = (unsigned)_a; _w.y = (unsigned)_b; *(MG_LAS u32x2*)(lds + MG_SB(b) + bwr[_i]) = _w; } } while (0)
#define MG_MMA(ai, At) do { typedef long l2_ __attribute__((ext_vector_type(2))); _Pragma("unroll") for (int m = 0; m < 4; ++m) _Pragma("unroll") for (int n = 0; n < 2; ++n) _Pragma("unroll") for (int k = 0; k < 2; ++k) { \
        const l2_ b_ = __builtin_bit_cast(l2_, Bf[n][k]), a_ = __builtin_bit_cast(l2_, At[m][k]); \
        acc[ai][m][n] = __builtin_amdgcn_mfma_f32_16x16x32_fp8_fp8(b_.x, a_.x, acc[ai][m][n], 0, 0, 0); acc[ai][m][n] = __builtin_amdgcn_mfma_f32_16x16x32_fp8_fp8(b_.y, a_.y, acc[ai][m][n], 0, 0, 0); } } while (0)
#define MG_WAIT_V(n) asm volatile("s_waitcnt vmcnt(" #n ")" ::: "memory")
#define MG_WAIT_L(n) asm volatile("s_waitcnt lgkmcnt(" #n ")" ::: "memory")
#define MG_BAR __builtin_amdgcn_s_barrier()
#define MG_SCHED __builtin_amdgcn_sched_barrier(0)
#define MG_GATH(gp) do { if constexpr (GATHER) { _Pragma("unroll") for (int _i = 0; _i < 2; ++_i) { const int R_ = 8 * wid + 64 * _i + (lane >> 3), C_ = 8 * ((lane ^ (lane >> 3)) & 7); \
        voffA[0][_i] = (unsigned)((gp)[R_] * lda + C_) * 2u; voffA[1][_i] = (unsigned)((gp)[R_ + 128] * lda + C_) * 2u; } } } while (0)
    Unit cu, au, bu; int ia = 0, ib = 0, ic = 0;
    if (!S.next(0, cu)) return;
    au = cu; bu = cu;
    const char* pa = au.A; int ta = 0; bool aend = false;
    const float* pb = BMap::src(bu, 4 * ng) + (size_t)brow * ldw; int tb = 0; bool bend = false;
    MG_GATH(au.gath);
#define MG_ADV_A() do { ++ta; pa += kstepA; if (ta == nt) { Unit nu_; if (!aend && S.next(ia + 1, nu_)) { ++ia; au = nu_; pa = au.A; ta = 0; MG_GATH(au.gath); } else { aend = true; ta = nt - 1; pa -= kstepA; } } } while (0)
#define MG_ADV_B() do { ++tb; pb += kstepB; if (tb == nt) { Unit nu_; if (!bend && S.next(ib + 1, nu_)) { ++ib; bu = nu_; pb = BMap::src(bu, 4 * ng) + (size_t)brow * ldw; tb = 0; } else { bend = true; tb = nt - 1; pb -= kstepB; } } } while (0)
    f32x4 acc[2][4][2];
#pragma unroll
    for (int a = 0; a < 2; ++a)
#pragma unroll
        for (int m = 0; m < 4; ++m)
#pragma unroll
            for (int n = 0; n < 2; ++n) acc[a][m][n] = (f32x4){0.f, 0.f, 0.f, 0.f};
    bf16x8 At0[4][2], At1[4][2], Bf[2][2];
    f32x4 Bx[8];
    MG_BLOAD(Bx, pb); MG_ADV_B();
    MG_DMA_A(0, pa); MG_ADV_A();
    MG_DMA_A(1, pa); MG_ADV_A();
    MG_WAIT_B(Bx);
    MG_BWRITE(Bx, 0);
    MG_BLOAD(Bx, pb); MG_ADV_B();
    MG_WAIT_L(0); MG_BAR;
    if (wr == 1) MG_BAR;
    int slot = 0;
#define MG_STEP(bcur, bnext) do { \
        const int s2_ = (slot == 0) ? 2 : slot - 1;                        \
        MG_LDB(Bf, bcur); MG_SCHED; MG_LDA(At0, slot, 0); MG_LDA(At1, slot, 1); \
        MG_DMA_A(s2_, pa); MG_ADV_A(); \
        MG_WAIT_B(Bx); \
        MG_BWRITE(Bx, bnext); \
        MG_BLOAD(Bx, pb); MG_ADV_B(); \
        MG_WAIT_L(0); MG_BAR; \
        __builtin_amdgcn_s_setprio(1); MG_MMA(0, At0); if (cu.nv > 128) { MG_MMA(1, At1); } __builtin_amdgcn_s_setprio(0); \
        MG_BAR; MG_SCHED; \
        slot = (slot == 2) ? 0 : slot + 1; } while (0)
    for (;;) {
#pragma unroll 1
        for (int t = 0; t < nt; t += 2) { MG_STEP(0, 1); MG_STEP(1, 0); }
        E(acc, cu, wr, wc, fr, fq);
        Unit nu;
        if (!S.next(ic + 1, nu)) break;
        ++ic; cu = nu;
#pragma unroll
        for (int a = 0; a < 2; ++a)
#pragma unroll
            for (int m = 0; m < 4; ++m)
#pragma unroll
                for (int n = 0; n < 2; ++n) acc[a][m][n] = (f32x4){0.f, 0.f, 0.f, 0.f};
    }
    MG_WAIT_V(0);
    if (wr == 0) MG_BAR;
    MG_BAR;
#undef MG_SA
#undef MG_SB
#undef MG_DMA_A
#undef MG_LDA
#undef MG_LDB
#undef MG_BLOAD
#undef MG_WAIT_B
#undef MG_BWRITE
#undef MG_MMA
#undef MG_WAIT_V
#undef MG_WAIT_L
#undef MG_BAR
#undef MG_SCHED
#undef MG_GATH
#undef MG_ADV_A
#undef MG_ADV_B
#undef MG_STEP
}
}
namespace attn_body {
using bf16=__hip_bfloat16;
using bf16x8=__attribute__((ext_vector_type(8)))short;
using s16x4=__attribute__((ext_vector_type(4)))short;
using f32x16=__attribute__((ext_vector_type(16)))float;
using u32x4=__attribute__((ext_vector_type(4)))unsigned;
constexpr int BATCH=2,NHEAD=8,SEQ=8192,D=64,PQ=1536,PO=1024;
constexpr int NW=8,QBLK=32,QB=QBLK*NW,KVBLK=64,NQB=SEQ/QB;
constexpr int ATTN_UNIT_ROWS=QB;
__device__ __forceinline__ int crow(int r,int hi){return (r&3)+8*(r>>2)+4*hi;}
#define SBAR() __builtin_amdgcn_sched_barrier(0)
__device__ __forceinline__ void cmask(f32x16&p0,f32x16&p1,int jb,int qrel,int hi){
  const float NEG=-INFINITY; int kb=64*jb+4*hi;
  #pragma unroll
  for(int r=0;r<16;++r){int kv=kb+(r&3)+8*(r>>2); if(kv>qrel)p0[r]=NEG; if(kv+32>qrel)p1[r]=NEG;}
}

constexpr int NSLOT=3, SLOTB=8192;
constexpr int LDS_K=0, LDS_V=NSLOT*SLOTB, LDS_WS=3*NSLOT*SLOTB, LDS_OST=LDS_WS+NW*64*4, LDS_BYTES=LDS_OST+NW*4096;
constexpr float C2=0.125f*1.4426950408889634f;
__device__ __forceinline__ void glds16(const void*gsrc,unsigned lds_dst){unsigned keep;
  asm volatile("s_mov_b32 %0, m0\n\ts_mov_b32 m0, %2\n\ts_nop 0\n\tglobal_load_lds_dwordx4 %1, off\n\ts_mov_b32 m0, %0":"=&s"(keep):"v"(gsrc),"s"(lds_dst):"memory");}
__device__ __forceinline__ float max3f(float a,float b,float c){float r;asm("v_max3_f32 %0, %1, %2, %3":"=v"(r):"v"(a),"v"(b),"v"(c));return r;}
__device__ __forceinline__ float max2f(float a,float b){float r;asm("v_max_f32_e32 %0, %1, %2":"=v"(r):"v"(a),"v"(b));return r;}
__device__ __forceinline__ float fadd_s(float a,float b){float r;asm("v_add_f32_e32 %0, %1, %2":"=v"(r):"v"(a),"v"(b));return r;}
__device__ __forceinline__ float fsub_s(float a,float b){float r;asm("v_sub_f32_e32 %0, %1, %2":"=v"(r):"v"(a),"v"(b));return r;}
typedef float f32x2_t __attribute__((ext_vector_type(2))); typedef __bf16 bf16x2_t __attribute__((ext_vector_type(2)));
__device__ __forceinline__ unsigned cvtpk_s(float lo,float hi){f32x2_t v={lo,hi};bf16x2_t b=__builtin_convertvector(v,bf16x2_t);return __builtin_bit_cast(unsigned,b);}
#define WAIT_BAR(N) asm volatile("s_waitcnt vmcnt(" #N ") lgkmcnt(0)\n\ts_barrier":::"memory")

__device__ __forceinline__ void qkt(f32x16&p0,f32x16&p1,const char*Kslot,const bf16x8*qr,int r32,int hi){ const f32x16 negm=f32x16{};
  const char*kb=Kslot+hi*1024+r32*16;
  #pragma unroll
  for(int d0=0;d0<4;++d0){
    const bf16x8 b0=*reinterpret_cast<const bf16x8*>(kb+d0*2048);
    const bf16x8 b1=*reinterpret_cast<const bf16x8*>(kb+d0*2048+512);
    if(d0==0){p0=__builtin_amdgcn_mfma_f32_32x32x16_bf16(b0,qr[0],negm,0,0,0);p1=__builtin_amdgcn_mfma_f32_32x32x16_bf16(b1,qr[0],negm,0,0,0);}
    else{p0=__builtin_amdgcn_mfma_f32_32x32x16_bf16(b0,qr[d0],p0,0,0,0);p1=__builtin_amdgcn_mfma_f32_32x32x16_bf16(b1,qr[d0],p1,0,0,0);}}
}
typedef __attribute__((address_space(3))) const char* lds_cptr;
typedef short v4i16_t __attribute__((ext_vector_type(4)));
__device__ __forceinline__ void kload8(bf16x8*kf,lds_cptr kp){
  kf[0]=*(const __attribute__((address_space(3))) bf16x8*)(kp);      kf[1]=*(const __attribute__((address_space(3))) bf16x8*)(kp+512);
  kf[2]=*(const __attribute__((address_space(3))) bf16x8*)(kp+2048); kf[3]=*(const __attribute__((address_space(3))) bf16x8*)(kp+2560);
  kf[4]=*(const __attribute__((address_space(3))) bf16x8*)(kp+4096); kf[5]=*(const __attribute__((address_space(3))) bf16x8*)(kp+4608);
  kf[6]=*(const __attribute__((address_space(3))) bf16x8*)(kp+6144); kf[7]=*(const __attribute__((address_space(3))) bf16x8*)(kp+6656);
}
__device__ __forceinline__ void kload2(bf16x8*kf,lds_cptr kp,int j){ kf[2*j]=*(const __attribute__((address_space(3))) bf16x8*)(kp+j*2048); kf[2*j+1]=*(const __attribute__((address_space(3))) bf16x8*)(kp+j*2048+512); }
__device__ __forceinline__ s16x4 vtr(lds_cptr p){ return __builtin_bit_cast(s16x4,__builtin_amdgcn_ds_read_tr16_b64_v4i16((__attribute__((address_space(3))) v4i16_t*)p)); }
__device__ __forceinline__ float rowmax(const f32x16&p0,const f32x16&p1){
  float a=max3f(p0[0],p0[1],p1[0]),b=max3f(p0[2],p0[3],p1[1]);a=max3f(a,p1[2],p1[3]);
  #pragma unroll
  for(int r=4;r<16;r+=4){a=max3f(a,p0[r],p0[r+1]);b=max3f(b,p0[r+2],p0[r+3]);a=max3f(a,p1[r],p1[r+1]);b=max3f(b,p1[r+2],p1[r+3]);}
  const float m=max2f(a,b);
  auto rr=__builtin_amdgcn_permlane32_swap(__float_as_uint(m),__float_as_uint(m),false,false);
  return max2f(__uint_as_float(rr[0]),__uint_as_float(rr[1]));
}
__device__ __forceinline__ void pv(f32x16*o,int vb,bf16x8 pa0,bf16x8 pa1,bf16x8 pa2,bf16x8 pa3){
  #pragma unroll
  for(int d0=0;d0<4;++d0){s16x4 lo[4],hi[4];
    #pragma unroll
    for(int ks=0;ks<4;++ks){
      asm volatile("ds_read_b64_tr_b16 %0,%1 offset:%c2":"=&v"(lo[ks]):"v"(vb),"i"(d0*4096+ks*1024):"memory");
      asm volatile("ds_read_b64_tr_b16 %0,%1 offset:%c2":"=&v"(hi[ks]):"v"(vb),"i"(d0*4096+ks*1024+512):"memory");}
    asm volatile("s_waitcnt lgkmcnt(0)":::"memory");SBAR();
    #define PK(k) (bf16x8){lo[k][0],lo[k][1],lo[k][2],lo[k][3],hi[k][0],hi[k][1],hi[k][2],hi[k][3]}
    o[d0]=__builtin_amdgcn_mfma_f32_32x32x16_bf16(pa0,PK(0),o[d0],0,0,0);
    o[d0]=__builtin_amdgcn_mfma_f32_32x32x16_bf16(pa1,PK(1),o[d0],0,0,0);
    o[d0]=__builtin_amdgcn_mfma_f32_32x32x16_bf16(pa2,PK(2),o[d0],0,0,0);
    o[d0]=__builtin_amdgcn_mfma_f32_32x32x16_bf16(pa3,PK(3),o[d0],0,0,0);
    #undef PK
  }
}

#ifndef ATTN_STORE16
#define ATTN_STORE16(p,v) (*(u32x4*)(p)=(v))
#endif
template<int THRL> __device__ __forceinline__ void attn_unit(int b,int qcol,int kcol,int vcol,int ocol,int qb,const bf16*__restrict__ QKV,bf16*O,char*shm){
  int tid_=threadIdx.x; asm volatile("":"+v"(tid_)); const int tid=tid_,lane=tid&63,r32=lane&31,hi=lane>>5; const int wid=__builtin_amdgcn_readfirstlane(tid>>6);
  const long rowbase=(long)b*SEQ; const int q0=qb*QB;
  const bf16*Qw=QKV+(rowbase+q0+wid*QBLK)*PQ+qcol;
  const bf16*Kh=QKV+rowbase*PQ+kcol,*Vh=QKV+rowbase*PQ+vcol;
  const unsigned lds0=(unsigned)(uintptr_t)shm;
  float*wsf=(float*)(shm+LDS_WS)+wid*64;
  const bf16*ksrc=Kh+(long)lane*PQ+wid*8;
  const bf16*vsrc=Vh+(long)(16*(wid&3)+(lane>>2))*PQ+(wid>>2)*32+(lane&3)*8;
  const unsigned kdst=lds0+LDS_K+wid*1024, vdst=lds0+LDS_V+wid*1024;
  #define DMA_K(t,slot) glds16(ksrc+(long)(t)*KVBLK*PQ,(unsigned)__builtin_amdgcn_readfirstlane(kdst+(slot)))
  #define DMA_V(t,slot) do{ glds16(vsrc+(long)(t)*KVBLK*PQ,(unsigned)__builtin_amdgcn_readfirstlane(vdst+2*(slot))); glds16(vsrc+64+(long)(t)*KVBLK*PQ,(unsigned)__builtin_amdgcn_readfirstlane(vdst+2*(slot)+8192)); }while(0)
  const int vb0=(int)(lds0+LDS_V)+((lane>>4)&1)*32+(lane&3)*8+(4*hi+((lane&15)>>2))*64;
  const char*Kbase=shm+LDS_K; bf16x8 kf[8];
  const lds_cptr shm3=(lds_cptr)shm; const lds_cptr kp0=shm3+LDS_K+hi*1024+r32*16; const lds_cptr vp0=shm3+LDS_V+((lane>>4)&1)*32+(lane&3)*8+(4*hi+((lane&15)>>2))*64;
  const int NT=(q0+QB)/KVBLK;
  DMA_K(0,0);DMA_V(0,0);DMA_K(1,SLOTB);
  bf16x8 qr[4];
  #pragma unroll
  for(int d0=0;d0<4;++d0)qr[d0]=*reinterpret_cast<const bf16x8*>(&Qw[(long)r32*PQ+d0*16+hi*8]);
  float mhat=0.f,l_reg=0.f;f32x16 o[4];o[0]=f32x16{};o[1]=f32x16{};o[2]=f32x16{};o[3]=f32x16{};
  const int qrel=wid*QBLK+r32;
  #define CMASK(P0,P1,t) do{int jb_=(t)-(NT-4); if(jb_>=0)cmask(P0,P1,jb_,qrel,hi);}while(0)
  bool resc=false;
  #define START(P0,P1) do{ const float rm=rowmax(P0,P1); resc=false; mhat=rm; \
    _Pragma("unroll") for(int r=0;r<16;++r)P0[r]=__builtin_amdgcn_exp2f(fsub_s(P0[r],mhat)); }while(0)
  #define RESC() do{ if(resc){ asm volatile("s_waitcnt lgkmcnt(0)":::"memory"); \
      _Pragma("unroll") for(int d_=0;d_<4;++d_) _Pragma("unroll") for(int r=0;r<16;++r)o[d_][r]*=wsf[crow(r,hi)]; } }while(0)
  f32x16 pA0,pA1,pB0,pB1;
  int sl_prev=0,sl_cur=0,sl_next=SLOTB;
  #define ROT() do{sl_prev=sl_cur;sl_cur=sl_next;sl_next=(sl_next==(NSLOT-1)*SLOTB)?0:sl_next+SLOTB;}while(0)
  DMA_K(2,2*SLOTB);
  WAIT_BAR(4);
  qkt(pA0,pA1,Kbase,qr,r32,hi);asm volatile("s_nop 15\n\ts_nop 7":"+v"(pA0),"+v"(pA1));CMASK(pA0,pA1,0);
  START(pA0,pA1);
  _Pragma("unroll") for(int r=0;r<16;++r)pA1[r]=__builtin_amdgcn_exp2f(pA1[r]-mhat);
  WAIT_BAR(0);
  DMA_K(3,0);DMA_V(1,SLOTB);
  ROT();
  kload8(kf,kp0+sl_cur);
  WAIT_BAR(3);
  s16x4 vlo[8],vhi[8]; u32x4 pw0,pw1,pw2,pw3;
  #define PKW(P,B) cvtpk_s(P[B],P[B+1])
  #define PAF(k) __builtin_bit_cast(bf16x8,pw##k)
  #define VFR(i) (bf16x8){vlo[i][0],vlo[i][1],vlo[i][2],vlo[i][3],vhi[i][0],vhi[i][1],vhi[i][2],vhi[i][3]}
  #define PIN(x) asm volatile("":"+v"(x))
  #define MX3(a,b,c) __builtin_fmaxf(__builtin_fmaxf((a),(b)),(c))
  #define GAPA(MF,A0,A1,A2,A3,W0,W1,PW) do{ MF; sacc+=A0; sacc+=A1; sacc+=A2; sacc+=A3; PIN(sacc); W0; W1; PIN(PW); SBAR(); }while(0)
  #define EX(v) __builtin_amdgcn_exp2f(v)
  #define GAPB(MF,X,B,RD) do{ MF; X[B]=EX(X[B]-mhat); X[B+1]=EX(X[B+1]-mhat); PIN(X); RD; SBAR(); }while(0)
  #define VRD(i) do{ vlo[i]=vtr(vp_+(((i)>>2)*4096+((i)&3)*1024)); vhi[i]=vtr(vp_+(((i)>>2)*4096+((i)&3)*1024+512)); }while(0)
  #define VRD2(i) do{ vlo[i]=vtr(vp_+((((i)>>2)+2)*4096+((i)&3)*1024)); vhi[i]=vtr(vp_+((((i)>>2)+2)*4096+((i)&3)*1024+512)); }while(0)
  #define NORD do{}while(0)
  #define KRD(G,j) do{ if(G){ kload2(kf,kp0+sl_next,j); SBAR(); } }while(0)
  #define STEP(C0,C1,P0,P1,t,GK,GV,GL) do{ SBAR(); \
    const lds_cptr vp_=vp0+2*sl_prev; \
    VRD(0); SBAR(); float sacc=(P0[0]+P0[1]); \
    GAPA(C0=__builtin_amdgcn_mfma_f32_32x32x16_bf16(kf[0],qr[0],f32x16{},0,0,0), P0[2],P0[3],P0[4],P0[5],     pw0[0]=PKW(P0,0), pw0[1]=PKW(P0,2), pw0); \
    VRD(4); SBAR(); GAPA(C1=__builtin_amdgcn_mfma_f32_32x32x16_bf16(kf[1],qr[0],f32x16{},0,0,0), P0[6],P0[7],P0[8],P0[9],     pw0[2]=PKW(P0,4), pw0[3]=PKW(P0,6), pw0); \
    VRD(1); SBAR(); GAPA(C0=__builtin_amdgcn_mfma_f32_32x32x16_bf16(kf[2],qr[1],C0,0,0,0),   P0[10],P0[11],P0[12],P0[13], pw1[0]=PKW(P0,8), pw1[1]=PKW(P0,10), pw1); \
    VRD(5); SBAR(); GAPA(C1=__builtin_amdgcn_mfma_f32_32x32x16_bf16(kf[3],qr[1],C1,0,0,0),   P0[14],P0[15],P1[0],P1[1],   pw1[2]=PKW(P0,12),pw1[3]=PKW(P0,14), pw1); \
    VRD(2); SBAR(); GAPA(C0=__builtin_amdgcn_mfma_f32_32x32x16_bf16(kf[4],qr[2],C0,0,0,0),   P1[2],P1[3],P1[4],P1[5],     pw2[0]=PKW(P1,0), pw2[1]=PKW(P1,2), pw2); \
    VRD(6); SBAR(); GAPA(C1=__builtin_amdgcn_mfma_f32_32x32x16_bf16(kf[5],qr[2],C1,0,0,0),   P1[6],P1[7],P1[8],P1[9],     pw2[2]=PKW(P1,4), pw2[3]=PKW(P1,6), pw2); \
    VRD(3); SBAR(); GAPA(C0=__builtin_amdgcn_mfma_f32_32x32x16_bf16(kf[6],qr[3],C0,0,0,0),   P1[10],P1[11],P1[12],P1[13], pw3[0]=PKW(P1,8), pw3[1]=PKW(P1,10), pw3); \
    VRD(7); SBAR(); GAPA(C1=__builtin_amdgcn_mfma_f32_32x32x16_bf16(kf[7],qr[3],C1,0,0,0),   P1[14],P1[15],0.f,0.f,       pw3[2]=PKW(P1,12),pw3[3]=PKW(P1,14), pw3); \
    l_reg+=sacc; \
    if(GK){DMA_K((t)+3,sl_cur);} if(GV){DMA_V((t)+1,sl_next);} \
    CMASK(C0,C1,t); \
    { float a=MX3(C0[0],C0[1],C1[0]),b=MX3(C0[2],C0[3],C1[1]); a=MX3(a,C1[2],C1[3]); \
      _Pragma("unroll") for(int r=4;r<16;r+=4){a=MX3(a,C0[r],C0[r+1]);b=MX3(b,C0[r+2],C0[r+3]);a=MX3(a,C1[r],C1[r+1]);b=MX3(b,C1[r+2],C1[r+3]);} \
      float rm=__builtin_fmaxf(a,b); { auto rr=__builtin_amdgcn_permlane32_swap(__float_as_uint(rm),__float_as_uint(rm),false,false); rm=__builtin_fmaxf(__uint_as_float(rr[0]),__uint_as_float(rr[1])); } \
      rm-=mhat; resc=false; \
      if(__builtin_expect(__any(rm>(float)THRL),0)){ const float dl=__builtin_fmaxf(rm,0.f); mhat+=dl; \
        const float f=__builtin_amdgcn_exp2f(-dl); l_reg*=f; if(hi==0)wsf[r32]=f; resc=true; } } \
    SBAR(); \
    GAPB(o[0]=__builtin_amdgcn_mfma_f32_32x32x16_bf16(PAF(0),VFR(0),o[0],0,0,0), C0,0, VRD2(0)); \
    GAPB(o[1]=__builtin_amdgcn_mfma_f32_32x32x16_bf16(PAF(0),VFR(4),o[1],0,0,0), C0,2, VRD2(4)); \
    KRD(GL,0); GAPB(o[0]=__builtin_amdgcn_mfma_f32_32x32x16_bf16(PAF(1),VFR(1),o[0],0,0,0), C0,4, VRD2(1)); \
    KRD(GL,1); GAPB(o[1]=__builtin_amdgcn_mfma_f32_32x32x16_bf16(PAF(1),VFR(5),o[1],0,0,0), C0,6, VRD2(5)); \
    KRD(GL,2); GAPB(o[0]=__builtin_amdgcn_mfma_f32_32x32x16_bf16(PAF(2),VFR(2),o[0],0,0,0), C0,8, VRD2(2)); \
    KRD(GL,3); GAPB(o[1]=__builtin_amdgcn_mfma_f32_32x32x16_bf16(PAF(2),VFR(6),o[1],0,0,0), C0,10, VRD2(6)); \
    GAPB(o[0]=__builtin_amdgcn_mfma_f32_32x32x16_bf16(PAF(3),VFR(3),o[0],0,0,0), C0,12, VRD2(3)); \
    GAPB(o[1]=__builtin_amdgcn_mfma_f32_32x32x16_bf16(PAF(3),VFR(7),o[1],0,0,0), C0,14, VRD2(7)); \
    GAPB(o[2]=__builtin_amdgcn_mfma_f32_32x32x16_bf16(PAF(0),VFR(0),o[2],0,0,0), C1,0, NORD); \
    GAPB(o[3]=__builtin_amdgcn_mfma_f32_32x32x16_bf16(PAF(0),VFR(4),o[3],0,0,0), C1,2, NORD); \
    GAPB(o[2]=__builtin_amdgcn_mfma_f32_32x32x16_bf16(PAF(1),VFR(1),o[2],0,0,0), C1,4, NORD); \
    GAPB(o[3]=__builtin_amdgcn_mfma_f32_32x32x16_bf16(PAF(1),VFR(5),o[3],0,0,0), C1,6, NORD); \
    GAPB(o[2]=__builtin_amdgcn_mfma_f32_32x32x16_bf16(PAF(2),VFR(2),o[2],0,0,0), C1,8, NORD); \
    GAPB(o[3]=__builtin_amdgcn_mfma_f32_32x32x16_bf16(PAF(2),VFR(6),o[3],0,0,0), C1,10, NORD); \
    GAPB(o[2]=__builtin_amdgcn_mfma_f32_32x32x16_bf16(PAF(3),VFR(3),o[2],0,0,0), C1,12, NORD); \
    GAPB(o[3]=__builtin_amdgcn_mfma_f32_32x32x16_bf16(PAF(3),VFR(7),o[3],0,0,0), C1,14, NORD); \
    }while(0)
  int t=1;
  #undef CMASK
  #define CMASK(P0,P1,t) do{}while(0)
  for(;t+5<NT;t+=2){
    STEP(pB0,pB1,pA0,pA1,t,true,true,true);     WAIT_BAR(3); RESC(); ROT();
    STEP(pA0,pA1,pB0,pB1,t+1,true,true,true);   WAIT_BAR(3); RESC(); ROT();
  }
  #undef CMASK
  #define CMASK(P0,P1,t) do{int jb_=(t)-(NT-4); if(jb_>=0)cmask(P0,P1,jb_,qrel,hi);}while(0)
  #define ENDW(tt) do{ if((tt)+3<NT){WAIT_BAR(3);} else if((tt)+2<NT){WAIT_BAR(2);} else {WAIT_BAR(0);} }while(0)
  for(;t+1<NT;t+=2){
    STEP(pB0,pB1,pA0,pA1,t,(t+3<NT),(t+1<NT),(t+1<NT));       ENDW(t);   RESC(); ROT();
    STEP(pA0,pA1,pB0,pB1,t+1,(t+4<NT),(t+2<NT),(t+2<NT));     ENDW(t+1); RESC(); ROT();
  }
  STEP(pB0,pB1,pA0,pA1,NT-1,false,false,false); RESC();
  { float sacc=pB0[0]+pB0[1]; _Pragma("unroll") for(int r=2;r<16;++r)sacc+=pB0[r]; _Pragma("unroll") for(int r=0;r<16;++r)sacc+=pB1[r]; l_reg+=sacc;
    pw0=(u32x4){PKW(pB0,0),PKW(pB0,2),PKW(pB0,4),PKW(pB0,6)};pw1=(u32x4){PKW(pB0,8),PKW(pB0,10),PKW(pB0,12),PKW(pB0,14)};pw2=(u32x4){PKW(pB1,0),PKW(pB1,2),PKW(pB1,4),PKW(pB1,6)};pw3=(u32x4){PKW(pB1,8),PKW(pB1,10),PKW(pB1,12),PKW(pB1,14)};
    SBAR(); pv(o,vb0+2*sl_cur,PAF(0),PAF(1),PAF(2),PAF(3)); }
  #undef PKW
  #undef PAF
  #undef VFR
  #undef PIN
  #undef MX3
  #undef GAPA
  #undef GAPB
  #undef EX
  #undef VRD
  #undef VRD2
  #undef NORD
  #undef KRD
  #undef STEP
  #undef ENDW
  {auto rr=__builtin_amdgcn_permlane32_swap(__float_as_uint(l_reg),__float_as_uint(l_reg),false,false);l_reg=__uint_as_float(rr[0])+__uint_as_float(rr[1]);}
  if(hi==0)wsf[32+r32]=l_reg;asm volatile("s_waitcnt lgkmcnt(0)":::"memory");
  float rli[16];
  #pragma unroll
  for(int r=0;r<16;++r)rli[r]=__builtin_amdgcn_rcpf(wsf[32+crow(r,hi)]);
  bf16*Ow=O+(rowbase+q0+wid*QBLK)*PO+ocol;
  { bf16*stg=(bf16*)(shm+LDS_OST)+wid*2048;
    #pragma unroll
    for(int ps=0;ps<2;++ps){
      #pragma unroll
      for(int r=0;r<16;++r){const int orow=crow(r,hi);
        #pragma unroll
        for(int d0=0;d0<2;++d0)stg[orow*64+d0*32+r32]=__float2bfloat16(o[2*ps+d0][r]*rli[r]);}
      asm volatile("s_waitcnt lgkmcnt(0)":::"memory");
      #pragma unroll
      for(int i=0;i<4;++i){const int row=i*8+(lane>>3),ch=lane&7; const u32x4 v=*(const u32x4*)(stg+row*64+ch*8); ATTN_STORE16(Ow+(long)row*PO+64*ps+ch*8,v);}
      asm volatile("s_waitcnt lgkmcnt(0)":::"memory"); } }
  asm volatile("s_waitcnt lgkmcnt(0)\n\ts_barrier":::"memory");
  #undef DMA_K
  #undef DMA_V
  #undef CMASK
  #undef START
  #undef RESC
  #undef ROT
}
constexpr int ATTN_LDS_BYTES=LDS_BYTES;
struct AttnTensors { const bf16* QKV; bf16* O; };
struct AttnUnit { int bh; int qb; };
struct StaticOrder {
  int vcu;
  __device__ __forceinline__ explicit StaticOrder(int grid,int block):vcu((block%8)*(grid/8)+block/8){}
  __device__ __forceinline__ bool next(int i,AttnUnit&u)const{ if(i>=2)return false; const int s=vcu&15; u.bh=vcu>>4; u.qb=(i==0)?s:31-s; return true; }
  __device__ __forceinline__ void a_ready(const AttnUnit&)const{}
  __device__ __forceinline__ void done(const AttnUnit&)const{}
};
struct QueueOrder {
  __attribute__((address_space(1))) unsigned* head; __attribute__((address_space(3))) int* slot; int xg;
  __device__ __forceinline__ bool next(int,AttnUnit&u)const{
    __syncthreads();
    if(threadIdx.x==0)*slot=(int)__hip_atomic_fetch_add(head,1u,__ATOMIC_RELAXED,__HIP_MEMORY_SCOPE_AGENT);
    __syncthreads();
    const int n=*slot; if(n>=64)return false; u.qb=31-(n>>1); u.bh=2*xg+(n&1); return true; }
  __device__ __forceinline__ void a_ready(const AttnUnit&)const{}
  __device__ __forceinline__ void done(const AttnUnit&)const{}
};
template<class Sched,int THRL=8> __device__ __forceinline__ void attn_phase(char*lds,const AttnTensors&T,const Sched&S){
  AttnUnit u;
  for(int i=0;S.next(i,u);++i){ S.a_ready(u); { const int vh=u.bh%NHEAD, h=vh>>1; attn_unit<THRL>(u.bh/NHEAD,vh*64,512+vh*64,1024+h*128,vh*128,u.qb,T.QKV,T.O,lds); }     S.done(u); }
}
#undef SBAR
#undef WAIT_BAR
}
namespace mk {
constexpr int NWAVES = 8;
constexpr int B_ = 2, L_ = 8192, D_ = 1024, M_ = B_ * L_;
constexpr int NE = 256, NEX = 257, TOPK = 8, NSLOT = M_ * TOPK, NSLOT_ALL = NSLOT + M_;
constexpr float NORM_EPS = 1e-6f, SUBLN_EPS = 1e-5f;
constexpr int NPHASE = 17;

constexpr size_t MiB = 1u << 20;
constexpr size_t WS_CTL = 0, CTL_ZERO_BYTES = 1 * MiB;
constexpr size_t WS_MOD = 1 * MiB, WS_LAMT = WS_MOD + 64 * 1024, WS_MODP = WS_MOD + 128 * 1024;
constexpr size_t WS_IDX = 2 * MiB, WS_RW = WS_IDX + 512 * 1024, WS_SLOTPOS = 3 * MiB, WS_SORTED = WS_SLOTPOS + 512 * 1024;
constexpr size_t WS_LOGITS = 5 * MiB;
constexpr size_t WS_WIN = 21 * MiB, WS_WOUT = 25 * MiB, WS_WGLU = 27 * MiB, WS_WR = WS_WGLU + 512 * 1024, WS_W2T = 28 * MiB, WS_W13T = 32 * MiB;
constexpr size_t WS_EGU = 40 * MiB, WS_EDN = 297 * MiB;
constexpr size_t WS_XN8 = 200 * MiB;
constexpr size_t WS_XN = 426 * MiB;
constexpr size_t WS_QKV = 458 * MiB, WS_UBUF = 506 * MiB, WS_SLOC = 530 * MiB, WS_G = 546 * MiB, WS_O = 562 * MiB, WS_CONCAT = 594 * MiB;
constexpr size_t WS_HBUF = 458 * MiB, WS_Y = 532 * MiB, WS_X1 = 820 * MiB, WS_ELIST = 884 * MiB, WS_END = 902 * MiB;
static_assert(WS_HBUF + (size_t)(NSLOT_ALL + 256) * 512 <= WS_Y && WS_Y + (size_t)NSLOT_ALL * 2048 <= WS_X1, "ws map");
static_assert(WS_SORTED + (size_t)(NSLOT_ALL + 256) * 4 <= WS_LOGITS, "ws map 2");
constexpr int CW_BAR = 4096, CW_COUNTS = 16384, CW_CURSOR = 32768, CSTR = 64, CW_SUB = 49152, CW_AQ = 49152 + 64, CW_CQ = 49152 + 64 * 16;

constexpr int RING_OFF = 0, RING_BYTES = 135168;
constexpr int TAB_OFF = RING_BYTES;
constexpr int TAB_TOFF = TAB_OFF, TAB_OFFS = TAB_OFF + 1040, TAB_DESC = TAB_OFF + 2080;
constexpr int LDSCTL_OFF = RING_BYTES + 4096, MISC_OFF = LDSCTL_OFF + 320;
constexpr int LDS_BYTES = 147456;
static_assert(MISC_OFF + 128 <= LDS_BYTES, "LDS map");

#define GAS __attribute__((address_space(1)))
#define LAS __attribute__((address_space(3)))
typedef unsigned short bf16;
typedef unsigned v4u __attribute__((ext_vector_type(4)));
typedef unsigned v2u __attribute__((ext_vector_type(2)));
typedef float f32x4 __attribute__((ext_vector_type(4)));
typedef GAS unsigned gu32;
#define RLX_AGENT __ATOMIC_RELAXED, __HIP_MEMORY_SCOPE_AGENT
#define LDS_WAIT() asm volatile("s_waitcnt lgkmcnt(0)" ::: "memory")
#define VM_WAIT() asm volatile("s_waitcnt vmcnt(0)" ::: "memory")
__device__ __forceinline__ unsigned f2bf(float f) { unsigned u = __builtin_bit_cast(unsigned, f); return (u + 0x7fffu + ((u >> 16) & 1u)) >> 16; }
__device__ __forceinline__ unsigned pk2(float lo, float hi) { return f2bf(lo) | (f2bf(hi) << 16); }
__device__ __forceinline__ unsigned pk4_fp8(float a, float b, float c, float d) { int w = __builtin_amdgcn_cvt_pk_fp8_f32(a, b, 0, false); w = __builtin_amdgcn_cvt_pk_fp8_f32(c, d, w, true); return (unsigned)w; }
__device__ __forceinline__ float bflo(unsigned w) { return __builtin_bit_cast(float, w << 16); }
__device__ __forceinline__ float bfhi(unsigned w) { return __builtin_bit_cast(float, w & 0xffff0000u); }
__device__ __forceinline__ float sigm(float x) { return 1.f / (1.f + __expf(-x)); }
__device__ __forceinline__ float gelu_t(float x) { const float z = 0.7978845608028654f * (x + 0.044715f * x * x * x); const float th = 1.f - 2.f / (1.f + __expf(2.f * z)); return 0.5f * x * (1.f + th); }

#define XB_TMO      128
#define XB_XCNT(j)  (256  + 64 * (j))
#define XB_XSUB(j)  (1280 + 64 * (j))
#define XB_XGEN(j)  (2304 + 64 * (j))
#define XB_TOP      3328
#define XB_TOPGEN   3392
#define XCD_BAR_WORDS 3456
#define XB_SPIN_CAP (1u << 18)
__device__ __forceinline__ unsigned xb_ld(unsigned* p)              { return __hip_atomic_load(p, __ATOMIC_RELAXED, __HIP_MEMORY_SCOPE_AGENT); }
__device__ __forceinline__ unsigned xb_add(unsigned* p, unsigned v) { return __hip_atomic_fetch_add(p, v, __ATOMIC_RELAXED, __HIP_MEMORY_SCOPE_AGENT); }
__device__ __forceinline__ unsigned xb_xcc_id() { return (unsigned)__builtin_amdgcn_s_getreg((3 << 11) | 20) & 0xFu; }
#define XB_SPIN(cond, bar) do { unsigned _sp = 0; while (cond) { __builtin_amdgcn_s_sleep(1); \
    if ((++_sp & 255u) == 0u) { if (xb_ld(&(bar)[XB_TMO])) break; if (_sp > XB_SPIN_CAP) { atomicAdd(&(bar)[XB_TMO], 1u); break; } } } } while (0)
struct XcdBarrier { unsigned* bar; unsigned x; volatile LAS unsigned* st; };
__device__ __forceinline__ XcdBarrier xcd_barrier_post(unsigned* bar, volatile LAS unsigned* st) {
    XcdBarrier b; b.bar = bar; b.x = xb_xcc_id(); b.st = st;
    if (threadIdx.x == 0) (void)xb_add(&bar[XB_XCNT(b.x)], 1u);
    return b;
}
__device__ __forceinline__ void xcd_barrier_complete(unsigned* bar, unsigned x, unsigned& nloc, unsigned& nx) {
    const unsigned G = gridDim.x * gridDim.y * gridDim.z;
    unsigned sum, cnt, mine, sp = 0u;
    for (;;) {
        sum = 0u; cnt = 0u; mine = 0u;
#pragma unroll
        for (unsigned j = 0; j < 16; ++j) { const unsigned c = xb_ld(&bar[XB_XCNT(j)]); sum += c; cnt += (c > 0u) ? 1u : 0u; mine = (j == x) ? c : mine; }
        if (sum == G) break;
        __builtin_amdgcn_s_sleep(1);
        if ((++sp & 255u) == 0u) { if (xb_ld(&bar[XB_TMO])) break; if (sp > XB_SPIN_CAP) { atomicAdd(&bar[XB_TMO], 1u); break; } }
    }
    nloc = mine > 0u ? mine : 1u; nx = cnt > 0u ? cnt : 1u;
}
__device__ __forceinline__ void xcd_barrier(const XcdBarrier& b) {
    asm volatile("s_waitcnt vmcnt(0)" ::: "memory");
    __syncthreads();
    if (threadIdx.x == 0) {
        unsigned* bar = b.bar;
        __builtin_amdgcn_s_waitcnt(0);
        unsigned nloc = b.st[0], nx = b.st[1];
        if (nloc == 0u) { xcd_barrier_complete(bar, b.x, nloc, nx); b.st[0] = nloc; b.st[1] = nx; }
        const unsigned old = xb_add(&bar[XB_XSUB(b.x)], 1u);
        const unsigned gen = old / nloc;
        if (old + 1u == (gen + 1u) * nloc) {
            __builtin_amdgcn_fence(__ATOMIC_RELEASE, "agent");
            asm volatile("s_waitcnt vmcnt(0)" ::: "memory");
            const unsigned og = xb_add(&bar[XB_TOP], 1u);
            const unsigned tg = og / nx;
            if (og + 1u == (tg + 1u) * nx) xb_add(&bar[XB_TOPGEN], 1u);
            else XB_SPIN(xb_ld(&bar[XB_TOPGEN]) == tg, bar);
            __builtin_amdgcn_fence(__ATOMIC_ACQUIRE, "agent");
            xb_add(&bar[XB_XGEN(b.x)], 1u);
            asm volatile("s_waitcnt vmcnt(0)" ::: "memory");
        } else {
            XB_SPIN(xb_ld(&bar[XB_XGEN(b.x)]) == gen, bar);
            __builtin_amdgcn_fence(__ATOMIC_ACQUIRE, "agent");
            asm volatile("s_waitcnt vmcnt(0)" ::: "memory");
        }
    }
    __syncthreads();
}

struct Args { const float* in[32]; float* out; unsigned char* ws; int ph_lo, ph_hi, variant, pad; };

struct Frame {
    LAS unsigned char* lds; volatile LAS unsigned* MISC; gu32* ctl;
    int tid, lane, wave, vcu, G;
};
__device__ __forceinline__ float wave_sum(float v) {
#pragma unroll
    for (int o = 1; o < 64; o <<= 1) v += __shfl_xor(v, o);
    return v;
}

__device__ __forceinline__ float wave_fsum_dpp(float v) {
#define FS_(ctrl, rm) v += __int_as_float(__builtin_amdgcn_update_dpp(0, __float_as_int(v), ctrl, rm, 0xf, false))
    FS_(0x111, 0xf); FS_(0x112, 0xf); FS_(0x114, 0xf); FS_(0x118, 0xf); FS_(0x142, 0xa); FS_(0x143, 0xc);
#undef FS_
    return __int_as_float(__builtin_amdgcn_readlane(__float_as_int(v), 63));
}

struct TrJob { const float* W; bf16* WT; int N, Kd; };
__device__ __forceinline__ void tr_load(f32x4 (&v)[8], const float* W, int N, int k0, int n0, int lane) {
    const int kc = lane & 7, ng = lane >> 3;
#pragma unroll
    for (int j = 0; j < 8; ++j) v[j] = __builtin_nontemporal_load((const GAS f32x4*)(W + (size_t)(k0 + 8 * kc + j) * N + n0 + 4 * ng));
}
__device__ __forceinline__ void tr_store(const f32x4 (&v)[8], bf16* WT, int Kd, int k0, int drow0, int lane) {
    const int kc = lane & 7, ng = lane >> 3;
#pragma unroll
    for (int i = 0; i < 4; ++i) { v4u o; o.x = pg8::cvt_pk_bf16(v[0][i], v[1][i]); o.y = pg8::cvt_pk_bf16(v[2][i], v[3][i]); o.z = pg8::cvt_pk_bf16(v[4][i], v[5][i]); o.w = pg8::cvt_pk_bf16(v[6][i], v[7][i]);
        *(GAS v4u*)(WT + (size_t)(drow0 + 4 * ng + i) * Kd + k0 + 8 * kc) = o; }
}
struct TrItem { const float* W; bf16* WT; int N, Kd, k0, n0, drow0; };
struct cplx { float r, i; };
__device__ __forceinline__ cplx cmul(cplx a, cplx b) { return {a.r * b.r - a.i * b.i, a.r * b.i + a.i * b.r}; }
__device__ __forceinline__ void ssm_lam(const float* a_re, const float* a_im, const float* lstep, int g, int p, float& lre, float& lim, float& dt) {
    lre = fminf(a_re[g * 64 + p], -1e-4f); lim = a_im[g * 64 + p]; dt = __expf(lstep[g]);
}
__device__ __forceinline__ cplx ssm_pow(float lre, float lim, float dt, float j) { const float er = __expf(lre * dt * j); float sn, cs; sincosf(lim * dt * j, &sn, &cs); return {er * cs, er * sn}; }
__device__ __forceinline__ cplx ssm_coef(float lre, float lim, float dt) {
    const cplx lb = ssm_pow(lre, lim, dt, 1.f); const float nr = lb.r - 1.f, ni = lb.i, den = lre * lre + lim * lim; return {(nr * lre + ni * lim) / den, (ni * lre - nr * lim) / den};
}

constexpr int NB8 = 2 * 64 * 257;
constexpr int NCONV = 12;
constexpr int C8_ROUTER = 0, C8_GLU = 0, C8_SSM = 0;
constexpr int C8_P2 = NB8 - C8_ROUTER, C8_P1 = C8_P2 - C8_GLU, C8_P0 = C8_P1 - C8_SSM;
struct P0In { const float *c, *w_ada, *b_ada, *w_in, *w_out, *w_glu, *w_router, *w_gate, *w_up, *w_down, *ws_gate, *ws_up, *ws_down, *a_re, *a_im, *lstep, *b_re, *b_im, *c_re, *c_im; };
__device__ __forceinline__ void conv8_range(const P0In& I, unsigned char* ws, int lo, int hi, int slot, int nslots, int lane) {
    unsigned char* EGU8 = ws + WS_EGU;
    auto dec8 = [&](int q, const float*& W, unsigned char*& WT, int& k0, int& n0, int& drow0) { const int e = q >> 7, up = (q >> 6) & 1, kb = (q >> 3) & 7, nb = q & 7;
        W = (e < NE) ? (up ? I.w_up : I.w_gate) + (size_t)e * 1024 * 256 : (up ? I.ws_up : I.ws_gate); WT = EGU8 + (size_t)e * 512 * 1024; k0 = 128 * kb; n0 = 32 * nb; drow0 = (n0 >> 7) * 256 + up * 128 + (n0 & 127); };
    for (int it = lo + slot; it < hi; it += 2 * nslots) {
        f32x4 v[2][16]; const float* W[2]; unsigned char* WT[2]; int k0[2], n0[2], d0[2]; const int kc = lane & 7, ng = lane >> 3;
#pragma unroll
        for (int u = 0; u < 2; ++u) { const int q = it + u * nslots; if (q < hi) { dec8(q, W[u], WT[u], k0[u], n0[u], d0[u]);
#pragma unroll
            for (int j = 0; j < 16; ++j) v[u][j] = __builtin_nontemporal_load((const GAS f32x4*)(W[u] + (size_t)(k0[u] + 16 * kc + j) * 256 + n0[u] + 4 * ng)); } }
#pragma unroll
        for (int u = 0; u < 2; ++u) { const int q = it + u * nslots; if (q < hi) {
#pragma unroll
            for (int i = 0; i < 4; ++i) { v4u o;
#pragma unroll
                for (int d = 0; d < 4; ++d) { int w_ = __builtin_amdgcn_cvt_pk_fp8_f32(v[u][4 * d][i] * 64.f, v[u][4 * d + 1][i] * 64.f, 0, false); w_ = __builtin_amdgcn_cvt_pk_fp8_f32(v[u][4 * d + 2][i] * 64.f, v[u][4 * d + 3][i] * 64.f, w_, true); o[d] = (unsigned)w_; }
                *(GAS v4u*)(WT[u] + (size_t)(d0[u] + 4 * ng + i) * 1024 + k0[u] + 16 * kc) = o; } } }
    }
}

__device__ __forceinline__ void conv_queues(const P0In& I, unsigned char* ws, gu32* heads, int xg, int lane) {
    { unsigned char* EGU8 = ws + WS_EGU; constexpr int PER = (NB8 + 7) / 8; gu32* head = heads + 64 * xg;
      auto dec8 = [&](int q, const float*& W, unsigned char*& WT, int& k0, int& n0, int& drow0) { const int e = q >> 7, up = (q >> 6) & 1, kb = (q >> 3) & 7, nb = q & 7;
          W = (e < NE) ? (up ? I.w_up : I.w_gate) + (size_t)e * 1024 * 256 : (up ? I.ws_up : I.ws_gate); WT = EGU8 + (size_t)e * 512 * 1024; k0 = 128 * kb; n0 = 32 * nb; drow0 = (n0 >> 7) * 256 + up * 128 + (n0 & 127); };
      for (;;) {
          int i0 = 0; if (lane == 0) i0 = (int)__hip_atomic_fetch_add(head, 3u, RLX_AGENT); i0 = __builtin_amdgcn_readfirstlane(i0);
          if (i0 >= PER) break;
          f32x4 v[3][16]; const float* W[3]; unsigned char* WT[3]; int k0[3], n0[3], d0[3]; const int kc = lane & 7, ng = lane >> 3;
#pragma unroll
          for (int u = 0; u < 3; ++u) { const int q = 8 * (i0 + u) + xg; if (q < NB8) { dec8(q, W[u], WT[u], k0[u], n0[u], d0[u]);
#pragma unroll
              for (int j = 0; j < 16; ++j) v[u][j] = __builtin_nontemporal_load((const GAS f32x4*)(W[u] + (size_t)(k0[u] + 16 * kc + j) * 256 + n0[u] + 4 * ng)); } }
#pragma unroll
          for (int u = 0; u < 3; ++u) { const int q = 8 * (i0 + u) + xg; if (q < NB8) {
#pragma unroll
              for (int i = 0; i < 4; ++i) { v4u o;
#pragma unroll
                  for (int d = 0; d < 4; ++d) { int w_ = __builtin_amdgcn_cvt_pk_fp8_f32(v[u][4 * d][i] * 64.f, v[u][4 * d + 1][i] * 64.f, 0, false); w_ = __builtin_amdgcn_cvt_pk_fp8_f32(v[u][4 * d + 2][i] * 64.f, v[u][4 * d + 3][i] * 64.f, w_, true); o[d] = (unsigned)w_; }
                  *(GAS v4u*)(WT[u] + (size_t)(d0[u] + 4 * ng + i) * 1024 + k0[u] + 16 * kc) = o; } } }
      } }
    { unsigned char* EDN8 = ws + WS_EDN; constexpr int ND = 257 * 64, PER = (ND + 7) / 8; gu32* head = heads + 64 * (8 + xg);
      for (;;) {
          int i0 = 0; if (lane == 0) i0 = (int)__hip_atomic_fetch_add(head, 3u, RLX_AGENT); i0 = __builtin_amdgcn_readfirstlane(i0);
          if (i0 >= PER) break;
          f32x4 v[3][16]; unsigned char* WT[3]; const int kc = lane & 7, ng = lane >> 3;
#pragma unroll
          for (int u = 0; u < 3; ++u) { const int q = 8 * (i0 + u) + xg; if (q < ND) { const int e = q >> 6, r = q & 63, kb = r >> 5, nb = r & 31;
              const float* W = ((e < NE) ? I.w_down + (size_t)e * 256 * 1024 : I.ws_down) + (size_t)(128 * kb + 16 * kc) * 1024 + 32 * nb + 4 * ng;
              WT[u] = EDN8 + (size_t)e * 1024 * 256 + (size_t)(32 * nb + 4 * ng) * 256 + 128 * kb + 16 * kc;
#pragma unroll
              for (int j = 0; j < 16; ++j) v[u][j] = __builtin_nontemporal_load((const GAS f32x4*)(W + (size_t)j * 1024)); } }
#pragma unroll
          for (int u = 0; u < 3; ++u) { const int q = 8 * (i0 + u) + xg; if (q < ND) {
#pragma unroll
              for (int i = 0; i < 4; ++i) { v4u o;
#pragma unroll
                  for (int d = 0; d < 4; ++d) { int w_ = __builtin_amdgcn_cvt_pk_fp8_f32(v[u][4 * d][i] * 64.f, v[u][4 * d + 1][i] * 64.f, 0, false); w_ = __builtin_amdgcn_cvt_pk_fp8_f32(v[u][4 * d + 2][i] * 64.f, v[u][4 * d + 3][i] * 64.f, w_, true); o[d] = (unsigned)w_; }
                  *(GAS v4u*)(WT[u] + (size_t)i * 256) = o; } } }
      } }
}
__device__ __forceinline__ void p0_prologue(Frame& F, const P0In& I, unsigned char* ws, int variant) {
    const int gw = F.vcu * NWAVES + F.wave, NGW = F.G * NWAVES, lane = F.lane;
    float* modp = (float*)(ws + WS_MODP); float* lamT = (float*)(ws + WS_LAMT);
    bf16* Win_t = (bf16*)(ws + WS_WIN); bf16* Wout_t = (bf16*)(ws + WS_WOUT); bf16* Wglu_t = (bf16*)(ws + WS_WGLU); bf16* Wr_t = (bf16*)(ws + WS_WR);
    bf16* W2t = (bf16*)(ws + WS_W2T); bf16* W13t = (bf16*)(ws + WS_W13T); bf16* EGU = (bf16*)(ws + WS_EGU); bf16* EDN = (bf16*)(ws + WS_EDN);
    int* sorted = (int*)(ws + WS_SORTED);
    constexpr int I_MOD = 96 * 16, I_S1 = 32 * 31, I_S2 = 32 * 16, I_S3 = 32 * 16, I_MISC = 1;
    constexpr int NITEMS = I_MOD + I_S1 + I_S2 + I_S3 + I_MISC;
    if (!(variant & 32)) for (int it = gw; it < NITEMS; it += NGW) {
        int r = it;
        if (r < I_S1) {
            const int g = r / 31, d = r % 31 - 15; const int c = lane >> 2, cp0 = (lane & 3) * 4;
            float kv[4] = {0.f, 0.f, 0.f, 0.f};
            if (d >= 0) {
                float lre, lim, dt; ssm_lam(I.a_re, I.a_im, I.lstep, g, lane, lre, lim, dt);
                const cplx z = cmul(ssm_pow(lre, lim, dt, (float)d), ssm_coef(lre, lim, dt));
                f32x4 br[4], bi[4]; float qr_[16], qi_[16];
#pragma unroll
                for (int j = 0; j < 4; ++j) { br[j] = *(const GAS f32x4*)(I.b_re + (g * 64 + lane) * 16 + 4 * j); bi[j] = *(const GAS f32x4*)(I.b_im + (g * 64 + lane) * 16 + 4 * j); }
#pragma unroll
                for (int cc = 0; cc < 16; ++cc) { const cplx q = cmul((cplx){I.c_re[(g * 16 + cc) * 64 + lane], I.c_im[(g * 16 + cc) * 64 + lane]}, z); qr_[cc] = q.r; qi_[cc] = q.i; }
#pragma unroll
                for (int cc = 0; cc < 16; ++cc)
#pragma unroll
                    for (int j = 0; j < 4; ++j)
#pragma unroll
                        for (int i = 0; i < 4; ++i) { const float tot = wave_fsum_dpp(qr_[cc] * br[j][i] - qi_[cc] * bi[j][i]);
                            if (lane == cc * 4 + j) kv[i] = tot; }
            }
            v2u o; o.x = pk2(kv[0], kv[1]); o.y = pk2(kv[2], kv[3]);
            for (int t = 0; t < 16; ++t) { const int s = t - d; if (s < 0 || s > 15) continue;
                *(GAS v2u*)(W13t + (size_t)(g * 256 + t * 16 + c) * 384 + s * 16 + cp0) = o; }
            continue; }
        r -= I_S1;
        if (r < I_S2) {
            const int g = r >> 4, t = r & 15; float lre, lim, dt; ssm_lam(I.a_re, I.a_im, I.lstep, g, lane, lre, lim, dt);
            const cplx pw = ssm_pow(lre, lim, dt, (float)(t + 1));
            for (int c = 0; c < 16; ++c) { const cplx cc = {I.c_re[(g * 16 + c) * 64 + lane], I.c_im[(g * 16 + c) * 64 + lane]}; const cplx q = cmul(cc, pw);
                *(GAS unsigned*)(W13t + (size_t)(g * 256 + t * 16 + c) * 384 + 256 + 2 * lane) = pk2(q.r, -q.i); }
            continue; }
        r -= I_S2;
        if (r < I_S3) {
            const int g = r >> 4, s = r & 15; float lre, lim, dt; ssm_lam(I.a_re, I.a_im, I.lstep, g, lane, lre, lim, dt);
            const cplx z = cmul(ssm_pow(lre, lim, dt, (float)(15 - s)), ssm_coef(lre, lim, dt));
            unsigned wr_[8], wi_[8];
#pragma unroll
            for (int c2 = 0; c2 < 8; ++c2) { const float br0 = I.b_re[(g * 64 + lane) * 16 + 2 * c2], bi0 = I.b_im[(g * 64 + lane) * 16 + 2 * c2], br1 = I.b_re[(g * 64 + lane) * 16 + 2 * c2 + 1], bi1 = I.b_im[(g * 64 + lane) * 16 + 2 * c2 + 1];
                wr_[c2] = pk2(z.r * br0 - z.i * bi0, z.r * br1 - z.i * bi1); wi_[c2] = pk2(z.r * bi0 + z.i * br0, z.r * bi1 + z.i * br1); }
            GAS v4u* dr = (GAS v4u*)(W2t + (size_t)(g * 256 + 2 * lane) * 256 + s * 16); GAS v4u* di = (GAS v4u*)(W2t + (size_t)(g * 256 + 2 * lane + 1) * 256 + s * 16);
            dr[0] = (v4u){wr_[0], wr_[1], wr_[2], wr_[3]}; dr[1] = (v4u){wr_[4], wr_[5], wr_[6], wr_[7]};
            di[0] = (v4u){wi_[0], wi_[1], wi_[2], wi_[3]}; di[1] = (v4u){wi_[4], wi_[5], wi_[6], wi_[7]};
            if (s == 0) { const cplx l16 = ssm_pow(lre, lim, dt, 16.f); lamT[(g * 64 + lane) * 2] = l16.r; lamT[(g * 64 + lane) * 2 + 1] = l16.i; }
            continue; }
        r -= I_S3;
        if (r < I_MISC) { for (int i = lane; i < 256; i += 64) sorted[NSLOT_ALL + i] = 0; continue; }
        r -= I_MISC;
        if (r < I_MOD) {
            const int jb = r % 96, ks = r / 96, j = jb * 64 + lane; float a0 = 0.f, a1 = 0.f;
#pragma unroll 16
            for (int kk = 0; kk < 64; ++kk) { const int k = ks * 64 + kk; const float w = I.w_ada[(size_t)k * 6 * D_ + j]; const float c0 = I.c[k], c1 = I.c[D_ + k];
                a0 += (c0 / (1.f + __expf(-c0))) * w; a1 += (c1 / (1.f + __expf(-c1))) * w; }
            if (ks == 0) { const float bb = I.b_ada[j]; a0 += bb; a1 += bb; }
            modp[(size_t)(ks * 2 + 0) * 6 * D_ + j] = a0; modp[(size_t)(ks * 2 + 1) * 6 * D_ + j] = a1; }
    }
    constexpr int T_WIN = 16 * 64, T_WOUT = 16 * 32, T_WGLU = 8 * 16, T_WR = 16 * 8, T_SH = 128, T_E = 256 * 128;
    constexpr int NTR = T_WIN + T_WOUT + T_WGLU + T_WR;
    auto decode = [&](int r, TrItem& t) {
        auto plain = [&](const float* W, int K, int N, bf16* WT, int q) { const int nblk = N / 32, kb = q / nblk, nb = q % nblk; t.W = W; t.WT = WT; t.N = N; t.Kd = K; t.k0 = 64 * kb; t.n0 = 32 * nb; t.drow0 = 32 * nb; };
        auto gu = [&](const float* W, bf16* WTe, int up, int q) { const int kb = q >> 3, nb = q & 7, n0 = 32 * nb; t.W = W; t.WT = WTe; t.N = 256; t.Kd = 1024; t.k0 = 64 * kb; t.n0 = n0; t.drow0 = (n0 >> 7) * 256 + up * 128 + (n0 & 127); };
        if (r < T_WIN) { plain(I.w_in, 1024, 2048, Win_t, r); return; } r -= T_WIN;
        if (r < T_WOUT) { plain(I.w_out, 1024, 1024, Wout_t, r); return; } r -= T_WOUT;
        if (r < T_WGLU) { plain(I.w_glu, 512, 512, Wglu_t, r); return; } r -= T_WGLU;
        if (r < T_WR) { plain(I.w_router, 1024, 256, Wr_t, r); return; } r -= T_WR;
        if (r < T_SH) { plain(I.ws_down, 256, 1024, EDN + (size_t)256 * 1024 * 256, r); return; } r -= T_SH;
        { const int e = r >> 7; plain(I.w_down + (size_t)e * 256 * 1024, 256, 1024, EDN + (size_t)e * 1024 * 256, r & 127); }
    };
    if (!(variant & 16)) for (int it = gw; it < NTR; it += 4 * NGW) {
        f32x4 v[4][8]; TrItem t[4];
#pragma unroll
        for (int u = 0; u < 4; ++u) { const int q = it + u * NGW; if (q < NTR) { decode(q, t[u]); tr_load(v[u], t[u].W, t[u].N, t[u].k0, t[u].n0, lane); } }
#pragma unroll
        for (int u = 0; u < 4; ++u) { const int q = it + u * NGW; if (q < NTR) tr_store(v[u], t[u].WT, t[u].Kd, t[u].k0, t[u].drow0, lane); }
    }
}

template <int NPART> __device__ __forceinline__ void norm_mod_rows(Frame& F, const float* x, const float* g, const float* mod, int shift_off, int scale_off, bf16* out, unsigned char* out8 = nullptr) {
    const int gw = F.vcu * NWAVES + F.wave, NGW = F.G * NWAVES, lane = F.lane;
    for (int b = 0; b < B_; ++b) {
        f32x4 gs[4], sh[4];
#pragma unroll
        for (int j = 0; j < 4; ++j) { const int c = 4 * lane + 256 * j; const f32x4 gg = *(const GAS f32x4*)(g + c); f32x4 sc = *(const GAS f32x4*)(mod + b * 6 * D_ + scale_off + c), sv = *(const GAS f32x4*)(mod + b * 6 * D_ + shift_off + c);
#pragma unroll
            for (int q = 1; q < NPART; ++q) { sc += *(const GAS f32x4*)(mod + (size_t)(q * 2 + b) * 6 * D_ + scale_off + c); sv += *(const GAS f32x4*)(mod + (size_t)(q * 2 + b) * 6 * D_ + shift_off + c); }
            gs[j] = gg * (sc + 1.0f); sh[j] = sv; }
        for (int m = b * L_ + gw; m < (b + 1) * L_; m += NGW) {
            const GAS f32x4* xr = (const GAS f32x4*)(x + (size_t)m * D_) + lane;
            f32x4 v[4]; float s = 0.f;
#pragma unroll
            for (int j = 0; j < 4; ++j) { v[j] = xr[64 * j]; s += (v[j].x * v[j].x + v[j].y * v[j].y) + (v[j].z * v[j].z + v[j].w * v[j].w); }
            const float rstd = rsqrtf(wave_sum(s) * (1.f / D_) + NORM_EPS);
            GAS v2u* o8 = (GAS v2u*)(out + (size_t)m * D_) + lane;
#pragma unroll
            for (int j = 0; j < 4; ++j) { const f32x4 y = v[j] * rstd * gs[j] + sh[j]; v2u w; w.x = pk2(y.x, y.y); w.y = pk2(y.z, y.w); o8[64 * j] = w;
                if (out8) *(GAS unsigned*)(out8 + (size_t)m * D_ + 4 * lane + 256 * j) = pk4_fp8(y.x, y.y, y.z, y.w); }
        }
    }
}

using pg8::Unit;
struct GridOrder {
    const char* A; const char* Bt; int lda, ldb, nM, nN, nwg, G, c;
    __device__ __forceinline__ bool next(int i, Unit& u) const {
        const long L = (long)i * G + c; if (L >= nwg) return false;
        int wgid = (int)L; { const int q = nwg / 8, r = nwg % 8, xcd = wgid % 8, off = wgid / 8; wgid = (xcd < r ? xcd * (q + 1) : r * (q + 1) + (xcd - r) * q) + off; }
        const int nig = 8 * nN, gid = wgid / nig, fm = gid * 8, gsz = (nM - fm) < 8 ? (nM - fm) : 8;
        u.pm = fm + ((wgid % nig) % gsz); u.pn = (wgid % nig) / gsz; u.r0 = 0; u.nv = 256; u.gath = nullptr;
        u.A = A + (size_t)u.pm * 256 * lda * 2; u.B = Bt + (size_t)u.pn * 256 * ldb * 2; return true;
    }
};
struct GroupOrder {
    const char* A; const char* Bt; int lda, ldb, nwg, G, c;
    __device__ __forceinline__ bool next(int i, Unit& u) const {
        const int L = i * G + c; if (L >= nwg) return false;
        u.pm = L; u.pn = L >> 2; u.r0 = 0; u.nv = 256; u.gath = nullptr;
        u.A = A + (size_t)L * 256 * lda * 2; u.B = Bt + (size_t)(L >> 2) * 256 * ldb * 2; return true;
    }
};
struct PairOrder {
    const char* A; const char* Bt; int lda, ldb, L0;
    __device__ __forceinline__ bool next(int i, Unit& u) const {
        if (i >= 2) return false; const int L = L0 + i;
        u.pm = L; u.pn = L >> 2; u.r0 = 0; u.nv = 256; u.gath = nullptr;
        u.A = A + (size_t)L * 256 * lda * 2; u.B = Bt + (size_t)(L >> 2) * 256 * ldb * 2; return true;
    }
};
__device__ __forceinline__ void wg_handover(Frame& F) {
    asm volatile("s_waitcnt vmcnt(0)" ::: "memory"); __syncthreads();
    if (F.tid == 0) { __builtin_amdgcn_fence(__ATOMIC_ACQUIRE, "agent"); asm volatile("s_waitcnt vmcnt(0)" ::: "memory"); }
    __syncthreads();
}
struct GluOrder {
    const char* A; const char* Bt; int sg;
    __device__ __forceinline__ bool next(int i, Unit& u) const {
        if (i >= 2) return false; const int L = sg + 64 * i;
        u.pm = L >> 1; u.pn = L & 1; u.r0 = 0; u.nv = 256; u.gath = nullptr; u.A = A + (size_t)u.pm * 256 * 512 * 2; u.B = Bt + (size_t)u.pn * 256 * 512 * 2; return true;
    }
};
__device__ __forceinline__ void sub_barrier(Frame& F, gu32* cnt, unsigned target) {
    asm volatile("s_waitcnt vmcnt(0)" ::: "memory"); __syncthreads();
    if (F.tid == 0) {
        __builtin_amdgcn_fence(__ATOMIC_RELEASE, "agent"); asm volatile("s_waitcnt vmcnt(0)" ::: "memory");
        (void)__hip_atomic_fetch_add(cnt, 1u, RLX_AGENT);
        unsigned sp = 0; while (__hip_atomic_load(cnt, RLX_AGENT) < target) { __builtin_amdgcn_s_sleep(2); if (++sp > (1u << 21)) break; }
        __builtin_amdgcn_fence(__ATOMIC_ACQUIRE, "agent"); asm volatile("s_waitcnt vmcnt(0)" ::: "memory");
    }
    __syncthreads();
}
template <int NJ, bool GATH> struct ExpertOrder {
    const LAS int* toff; const LAS int* offs; const LAS int* desc; const char* A; const char* Bt; const int* sorted; int G, c, ntot;
    __device__ __forceinline__ bool next(int i, Unit& u) const {
        const int L = i * G + c; if (L >= ntot) return false;
        const int e = desc[2 * i], mt = desc[2 * i + 1], j = L % NJ;
        const int o0 = offs[e], cnt = offs[e + 1] - o0;
        u.pm = e; u.pn = j; u.r0 = o0 + mt * 256; u.nv = cnt - mt * 256;
        if (GATH) { u.A = A; u.gath = sorted + u.r0; u.B = Bt + ((size_t)e * 2 + j) * 256 * 1024 * 2; }
        else { u.A = A + (size_t)u.r0 * 256 * 2; u.gath = nullptr; u.B = Bt + ((size_t)e * 4 + j) * 256 * 256 * 2; }
        return true;
    }
};
template <int NJ> __device__ __forceinline__ int build_expert_tables(Frame& F, const gu32* counts, int maxdesc) {
    LAS int* toff = (LAS int*)(F.lds + TAB_TOFF); LAS int* offs = (LAS int*)(F.lds + TAB_OFFS); LAS int* desc = (LAS int*)(F.lds + TAB_DESC);
    __syncthreads();
    if (F.wave == 0) {
        const int l = F.lane; int c[4], t[4]; int cs = 0, ts = 0;
#pragma unroll
        for (int i = 0; i < 4; ++i) { c[i] = (int)__hip_atomic_load(counts + (4 * l + i) * CSTR, RLX_AGENT); t[i] = (c[i] + 255) >> 8; cs += c[i]; ts += t[i]; }
        int ce = cs, te = ts;
#pragma unroll
        for (int o = 1; o < 64; o <<= 1) { const int a = __shfl_up(ce, o), b = __shfl_up(te, o); if (l >= o) { ce += a; te += b; } }
        int co = ce - cs, to = te - ts;
#pragma unroll
        for (int i = 0; i < 4; ++i) { offs[4 * l + i] = co; toff[4 * l + i] = to; co += c[i]; to += t[i]; }
        if (l == 63) { offs[256] = co; toff[256] = to; offs[257] = co + M_; toff[257] = to + M_ / 256; }
    }
    __syncthreads();
    const int ntiles = toff[257];
    if (F.tid < maxdesc) {
        const int L = F.tid * F.G + F.vcu, T = L / NJ; int e = 0, mt = 0;
        if (T < ntiles) { int lo = 0, hi = 257;
            while (hi - lo > 1) { const int mid = (lo + hi) >> 1; if (toff[mid] <= T) lo = mid; else hi = mid; }
            e = lo; mt = T - toff[lo]; }
        desc[2 * F.tid] = e; desc[2 * F.tid + 1] = mt;
    }
    __syncthreads();
    return ntiles * NJ;
}

using pg8::f32x4; using pg8::u32x4; using pg8::cvt_pk_bf16;
#define EPI_ARGS const f32x4 (&acc)[2][2][4][2], const Unit& u, int wr, int wc, int fr, int fq
struct EpiProj { static constexpr bool PERM = true; bf16* QKV; bf16* Ubuf; float c2;
    __device__ __forceinline__ void operator()(EPI_ARGS) const {
        const int colt = u.pn * 256; const float sc = (colt < 512) ? c2 : 1.f;
#pragma unroll
        for (int ai = 0; ai < 2; ++ai)
#pragma unroll
            for (int m = 0; m < 4; ++m) { const int row = u.pm * 256 + ai * 128 + wr * 64 + m * 16 + fr;
#pragma unroll
                for (int bj = 0; bj < 2; ++bj) { const int C = colt + bj * 128 + wc * 32 + 8 * fq; const f32x4 v0 = acc[ai][bj][m][0] * sc, v1 = acc[ai][bj][m][1] * sc;
                    u32x4 w; w.x = cvt_pk_bf16(v0[0], v0[1]); w.y = cvt_pk_bf16(v0[2], v0[3]); w.z = cvt_pk_bf16(v1[0], v1[1]); w.w = cvt_pk_bf16(v1[2], v1[3]);
                    if (colt < 1536) *(u32x4*)(QKV + (size_t)row * 1536 + C) = w;
                    else { const int ch = C - 1536, g = ch >> 4, cc = ch & 15; *(u32x4*)(Ubuf + ((size_t)(g * 1024 + (row >> 4)) * 384 + (row & 15) * 16 + cc)) = w; } } }
    } };
struct EpiSloc { static constexpr bool PERM = false; float* Sloc;
    __device__ __forceinline__ void operator()(EPI_ARGS) const {
#pragma unroll
        for (int ai = 0; ai < 2; ++ai)
#pragma unroll
            for (int m = 0; m < 4; ++m) { const int row = u.pm * 256 + ai * 128 + wr * 64 + m * 16 + fr;
#pragma unroll
                for (int n = 0; n < 2; ++n) *(f32x4*)(Sloc + (size_t)row * 128 + wc * 32 + 16 * n + 4 * fq) = acc[ai][0][m][n]; }
    } };
struct EpiSsm2 { static constexpr bool PERM = true; const bf16* Ubuf; const float* dskip; bf16* G;
    __device__ __forceinline__ void operator()(EPI_ARGS) const {
        const int g = u.pm >> 2;
#pragma unroll
        for (int ai = 0; ai < 2; ++ai)
#pragma unroll
            for (int m = 0; m < 4; ++m) { const int R = u.pm * 256 + ai * 128 + wr * 64 + m * 16 + fr, nch = R & 1023;
#pragma unroll
                for (int bj = 0; bj < 2; ++bj) { const int c0 = bj * 128 + wc * 32 + 8 * fq, t = c0 >> 4, cc = c0 & 15;
                    const u32x4 uu = *(const u32x4*)(Ubuf + (size_t)R * 384 + c0); const f32x4 d0 = *(const f32x4*)(dskip + g * 16 + cc), d1 = *(const f32x4*)(dskip + g * 16 + cc + 4);
                    const f32x4 a0 = acc[ai][bj][m][0], a1 = acc[ai][bj][m][1];
                    const float y0 = a0[0] + d0[0] * bflo(uu.x), y1 = a0[1] + d0[1] * bfhi(uu.x), y2 = a0[2] + d0[2] * bflo(uu.y), y3 = a0[3] + d0[3] * bfhi(uu.y);
                    const float y4 = a1[0] + d1[0] * bflo(uu.z), y5 = a1[1] + d1[1] * bfhi(uu.z), y6 = a1[2] + d1[2] * bflo(uu.w), y7 = a1[3] + d1[3] * bfhi(uu.w);
                    u32x4 w; w.x = cvt_pk_bf16(gelu_t(y0), gelu_t(y1)); w.y = cvt_pk_bf16(gelu_t(y2), gelu_t(y3)); w.z = cvt_pk_bf16(gelu_t(y4), gelu_t(y5)); w.w = cvt_pk_bf16(gelu_t(y6), gelu_t(y7));
                    *(u32x4*)(G + (size_t)(nch * 16 + t) * 512 + g * 16 + cc) = w; } }
    } };
struct EpiGlu { static constexpr bool PERM = true; const bf16* G; const float* bias; bf16* concat;
    __device__ __forceinline__ void operator()(EPI_ARGS) const {
#pragma unroll
        for (int ai = 0; ai < 2; ++ai)
#pragma unroll
            for (int m = 0; m < 4; ++m) { const int row = u.pm * 256 + ai * 128 + wr * 64 + m * 16 + fr;
#pragma unroll
                for (int bj = 0; bj < 2; ++bj) { const int C = u.pn * 256 + bj * 128 + wc * 32 + 8 * fq;
                    const u32x4 gg = *(const u32x4*)(G + (size_t)row * 512 + C); const f32x4 b0 = *(const f32x4*)(bias + C), b1 = *(const f32x4*)(bias + C + 4);
                    const f32x4 a0 = acc[ai][bj][m][0] + b0, a1 = acc[ai][bj][m][1] + b1;
                    u32x4 w; w.x = cvt_pk_bf16(bflo(gg.x) * sigm(a0[0]), bfhi(gg.x) * sigm(a0[1])); w.y = cvt_pk_bf16(bflo(gg.y) * sigm(a0[2]), bfhi(gg.y) * sigm(a0[3]));
                    w.z = cvt_pk_bf16(bflo(gg.z) * sigm(a1[0]), bfhi(gg.z) * sigm(a1[1])); w.w = cvt_pk_bf16(bflo(gg.w) * sigm(a1[2]), bfhi(gg.w) * sigm(a1[3]));
                    *(u32x4*)(concat + (size_t)row * 1024 + 512 + C) = w; } }
    } };
struct EpiRes { static constexpr bool PERM = false; const float* x; const float* mod; float* out;
    __device__ __forceinline__ void operator()(EPI_ARGS) const {
#pragma unroll
        for (int ai = 0; ai < 2; ++ai)
#pragma unroll
            for (int m = 0; m < 4; ++m) { const int row = u.pm * 256 + ai * 128 + wr * 64 + m * 16 + fr; const float* gp = mod + (row >> 13) * 6 * D_ + 2 * D_;
#pragma unroll
                for (int bj = 0; bj < 2; ++bj)
#pragma unroll
                    for (int n = 0; n < 2; ++n) { const int C = u.pn * 256 + bj * 128 + wc * 32 + 16 * n + 4 * fq; const size_t off = (size_t)row * D_ + C;
                        *(f32x4*)(out + off) = *(const f32x4*)(x + off) + *(const f32x4*)(gp + C) * acc[ai][bj][m][n]; } }
    } };
struct EpiLogits { static constexpr bool PERM = false; float* logits;
    __device__ __forceinline__ void operator()(EPI_ARGS) const {
#pragma unroll
        for (int ai = 0; ai < 2; ++ai)
#pragma unroll
            for (int m = 0; m < 4; ++m) { const int row = u.pm * 256 + ai * 128 + wr * 64 + m * 16 + fr;
#pragma unroll
                for (int bj = 0; bj < 2; ++bj)
#pragma unroll
                    for (int n = 0; n < 2; ++n) *(f32x4*)(logits + (size_t)row * 256 + bj * 128 + wc * 32 + 16 * n + 4 * fq) = acc[ai][bj][m][n]; }
    } };
struct EpiGateUp { static constexpr bool PERM = true; bf16* Hbuf; float s;
    __device__ __forceinline__ void operator()(EPI_ARGS) const {
#pragma unroll
        for (int ai = 0; ai < 2; ++ai)
#pragma unroll
            for (int m = 0; m < 4; ++m) { const int rr = ai * 128 + wr * 64 + m * 16 + fr;
                if (rr < u.nv) { const f32x4 g0 = acc[ai][0][m][0] * s, g1 = acc[ai][0][m][1] * s, u0 = acc[ai][1][m][0] * s, u1 = acc[ai][1][m][1] * s;
                    u32x4 w; w.x = cvt_pk_bf16(g0[0] * sigm(g0[0]) * u0[0], g0[1] * sigm(g0[1]) * u0[1]); w.y = cvt_pk_bf16(g0[2] * sigm(g0[2]) * u0[2], g0[3] * sigm(g0[3]) * u0[3]);
                    w.z = cvt_pk_bf16(g1[0] * sigm(g1[0]) * u1[0], g1[1] * sigm(g1[1]) * u1[1]); w.w = cvt_pk_bf16(g1[2] * sigm(g1[2]) * u1[2], g1[3] * sigm(g1[3]) * u1[3]);
                    *(u32x4*)(Hbuf + (size_t)(u.r0 + rr) * 256 + u.pn * 128 + wc * 32 + 8 * fq) = w; } }
    } };
struct EpiDown { static constexpr bool PERM = true; bf16* Y; int variant;
    __device__ __forceinline__ void operator()(EPI_ARGS) const {
#pragma unroll
        for (int ai = 0; ai < 2; ++ai)
#pragma unroll
            for (int m = 0; m < 4; ++m) { const int rr = ai * 128 + wr * 64 + m * 16 + fr;
                if (rr < u.nv && !(variant & 4)) {
#pragma unroll
                    for (int bj = 0; bj < 2; ++bj) { const f32x4 v0 = acc[ai][bj][m][0], v1 = acc[ai][bj][m][1];
                        u32x4 w; w.x = cvt_pk_bf16(v0[0], v0[1]); w.y = cvt_pk_bf16(v0[2], v0[3]); w.z = cvt_pk_bf16(v1[0], v1[1]); w.w = cvt_pk_bf16(v1[2], v1[3]);
                        *(u32x4*)(Y + (size_t)(u.r0 + rr) * 1024 + u.pn * 256 + bj * 128 + wc * 32 + 8 * fq) = w; } } }
    } };

struct EpiGateUp8 { static constexpr bool PERM = true; unsigned char* H8;
    __device__ __forceinline__ void operator()(EPI_ARGS) const {
        const float s = 1.f / 64.f;
#pragma unroll
        for (int ai = 0; ai < 2; ++ai)
#pragma unroll
            for (int m = 0; m < 4; ++m) { const int rr = ai * 128 + wr * 64 + m * 16 + fr;
                if (rr < u.nv) { const f32x4 g0 = acc[ai][0][m][0] * s, g1 = acc[ai][0][m][1] * s, u0 = acc[ai][1][m][0] * (s * 16.f), u1 = acc[ai][1][m][1] * (s * 16.f);
                    v2u w; w.x = pk4_fp8(g0[0] * sigm(g0[0]) * u0[0], g0[1] * sigm(g0[1]) * u0[1], g0[2] * sigm(g0[2]) * u0[2], g0[3] * sigm(g0[3]) * u0[3]);
                    w.y = pk4_fp8(g1[0] * sigm(g1[0]) * u1[0], g1[1] * sigm(g1[1]) * u1[1], g1[2] * sigm(g1[2]) * u1[2], g1[3] * sigm(g1[3]) * u1[3]);
                    *(v2u*)(H8 + (size_t)(u.r0 + rr) * 256 + u.pn * 128 + wc * 32 + 8 * fq) = w; } }
    } };
struct ExpertOrderD8 {
    const LAS int* offs; const LAS int* desc; const char* A; const char* Bt; int G, c, ntot;
    __device__ __forceinline__ bool next(int i, Unit& u) const {
        const int L = i * G + c; if (L >= ntot) return false;
        const int e = desc[2 * i], mt = desc[2 * i + 1], j = L & 3;
        const int o0 = offs[e], cnt = offs[e + 1] - o0;
        u.pm = e; u.pn = j; u.r0 = o0 + mt * 256; u.nv = cnt - mt * 256; u.gath = nullptr; u.A = A + (size_t)u.r0 * 256; u.B = Bt + ((size_t)e * 4 + j) * 256 * 256; return true;
    }
};
struct EpiDown8 { static constexpr bool PERM = true; static constexpr bool PERM16 = true; unsigned char* Y8;
    __device__ __forceinline__ void operator()(EPI_ARGS) const {
#pragma unroll
        for (int ai = 0; ai < 2; ++ai)
#pragma unroll
            for (int m = 0; m < 4; ++m) { const int rr = ai * 128 + wr * 64 + m * 16 + fr;
                if (rr < u.nv) { const f32x4 a = acc[ai][0][m][0] * (1.f / 64.f), b = acc[ai][0][m][1] * (1.f / 64.f), c = acc[ai][1][m][0] * (1.f / 64.f), d = acc[ai][1][m][1] * (1.f / 64.f);
                    v4u w; w.x = pk4_fp8(a[0], a[1], a[2], a[3]); w.y = pk4_fp8(b[0], b[1], b[2], b[3]); w.z = pk4_fp8(c[0], c[1], c[2], c[3]); w.w = pk4_fp8(d[0], d[1], d[2], d[3]);
                    *(v4u*)(Y8 + (size_t)(u.r0 + rr) * 1024 + u.pn * 256 + wc * 64 + 16 * fq) = w; } }
    } };
struct ExpertOrder8 {
    const LAS int* offs; const LAS int* desc; const char* A; const char* Bt; const int* sorted; int G, c, ntot;
    __device__ __forceinline__ bool next(int i, Unit& u) const {
        const int L = i * G + c; if (L >= ntot) return false;
        const int e = desc[2 * i], mt = desc[2 * i + 1], j = L & 1;
        const int o0 = offs[e], cnt = offs[e + 1] - o0;
        u.pm = e; u.pn = j; u.r0 = o0 + mt * 256; u.nv = cnt - mt * 256; u.A = A; u.gath = sorted + e * 16384 + mt * 256; u.B = Bt + ((size_t)e * 2 + j) * 256 * 1024; return true;
    }
};
struct XW { const float *gate, *up, *down, *sgate, *sup, *sdown; };
template <int NJ, bool GUP> struct ExpertOrderF {
    const LAS int* offs; const LAS int* desc; const char* A; XW w; const int* sorted; int G, c, ntot, variant;
    __device__ __forceinline__ bool next(int i, mg::Unit& u) const {
        const int L = i * G + c; if (L >= ntot) return false;
        const int e = desc[2 * i], mt = desc[2 * i + 1], j = L % NJ;
        const int o0 = offs[e], cnt = offs[e + 1] - o0;
        u.pm = e; u.pn = j; u.r0 = o0 + mt * 256; u.nv = cnt - mt * 256;
        const int ew = (variant & 1) ? 0 : e; const int ra = (variant & 2) ? 0 : u.r0;
        if (GUP) { u.A = A; u.gath = sorted + ra;
            u.B0 = (ew < NE ? w.gate + (size_t)ew * 1024 * 256 : w.sgate) + j * 64; u.B1 = (ew < NE ? w.up + (size_t)ew * 1024 * 256 : w.sup) + j * 64; }
        else { u.A = A + (size_t)ra * 256 * 2; u.gath = nullptr; u.B0 = (ew < NE ? w.down + (size_t)ew * 256 * 1024 : w.sdown) + j * 128; u.B1 = u.B0; }
        return true;
    }
};
#define EPIN_ARGS const f32x4 (&acc)[2][4][2], const mg::Unit& u, int wr, int wc, int fr, int fq
struct EpiGateUpN { bf16* Hbuf; float s;
    __device__ __forceinline__ void operator()(EPIN_ARGS) const {
#pragma unroll
        for (int ai = 0; ai < 2; ++ai)
#pragma unroll
            for (int m = 0; m < 4; ++m) { const int rr = ai * 128 + wr * 64 + m * 16 + fr;
                if (rr < u.nv) { const f32x4 g = acc[ai][m][0] * s, v = acc[ai][m][1] * s;
                    pg8::u32x2 w; w.x = cvt_pk_bf16(g[0] * sigm(g[0]) * v[0], g[1] * sigm(g[1]) * v[1]); w.y = cvt_pk_bf16(g[2] * sigm(g[2]) * v[2], g[3] * sigm(g[3]) * v[3]);
                    *(pg8::u32x2*)(Hbuf + (size_t)(u.r0 + rr) * 256 + u.pn * 64 + wc * 16 + 4 * fq) = w; } }
    } };
struct EpiDownN { bf16* Y;
    __device__ __forceinline__ void operator()(EPIN_ARGS) const {
#pragma unroll
        for (int ai = 0; ai < 2; ++ai)
#pragma unroll
            for (int m = 0; m < 4; ++m) { const int rr = ai * 128 + wr * 64 + m * 16 + fr;
                if (rr < u.nv) { const f32x4 v0 = acc[ai][m][0], v1 = acc[ai][m][1];
                    u32x4 w; w.x = cvt_pk_bf16(v0[0], v0[1]); w.y = cvt_pk_bf16(v0[2], v0[3]); w.z = cvt_pk_bf16(v1[0], v1[1]); w.w = cvt_pk_bf16(v1[2], v1[3]);
                    *(u32x4*)(Y + (size_t)(u.r0 + rr) * 1024 + u.pn * 128 + wc * 32 + 8 * fq) = w; } }
    } };

__global__ void __launch_bounds__(NWAVES * 64, 2) mega_fwd(Args args) {
    extern __shared__ __attribute__((aligned(16))) unsigned char lds[];
    Frame F;
    F.lds = (LAS unsigned char*)lds; F.MISC = (volatile LAS unsigned*)(F.lds + MISC_OFF);
    F.tid = threadIdx.x; F.lane = F.tid & 63; F.wave = __builtin_amdgcn_readfirstlane(F.tid >> 6);
    F.G = gridDim.x; { const int bx = blockIdx.x; F.vcu = (F.G % 8 == 0) ? (bx % 8) * (F.G / 8) + bx / 8 : bx; }
    unsigned char* ws = args.ws; F.ctl = (gu32*)(ws + WS_CTL);
    for (int u = F.tid; u < (LDS_BYTES - LDSCTL_OFF) / 4; u += NWAVES * 64) ((LAS unsigned*)(F.lds + LDSCTL_OFF))[u] = 0u;
    __syncthreads();
    const int lo = args.ph_lo, hi = args.ph_hi;
    const bool multi = (hi - lo) > 1;
    XcdBarrier bar; bar.bar = (unsigned*)(F.ctl + CW_BAR); bar.x = 0; bar.st = nullptr;
    if (multi) bar = xcd_barrier_post((unsigned*)(F.ctl + CW_BAR), F.MISC + 8);
#ifndef PHASE_MASK
#define PHASE_MASK 0x1ffff
#endif
#define IN(k) (((PHASE_MASK >> (k)) & 1) && lo <= (k) && (k) < hi)
#ifndef REPEAT_MASK
#define REPEAT_MASK 0
#endif
#define NREP(k) ((((REPEAT_MASK) >> (k)) & 1) + 1)
#if REPEAT_MASK
#define PH(k) for (int rep_ = 0; rep_ < NREP(k); ++rep_) if (IN(k) && (rep_ == 0 || (xcd_barrier(bar), true)))
#else
#define PH(k) if (IN(k))
#endif
#define SEAM(k) do { if (IN(k) && IN((k) + 1)) xcd_barrier(bar); } while (0)
    const float* x = args.in[0]; float* out = args.out;
#define mod ((float*)(ws + WS_MOD))
#define lamT ((float*)(ws + WS_LAMT))
#define idx ((int*)(ws + WS_IDX))
#define rw ((float*)(ws + WS_RW))
#define slotpos ((int*)(ws + WS_SLOTPOS))
#define sorted ((int*)(ws + WS_SORTED))
#define logits ((float*)(ws + WS_LOGITS))
#define Win_t ((bf16*)(ws + WS_WIN))
#define Wout_t ((bf16*)(ws + WS_WOUT))
#define Wglu_t ((bf16*)(ws + WS_WGLU))
#define Wr_t ((bf16*)(ws + WS_WR))
#define W2t ((bf16*)(ws + WS_W2T))
#define W13t ((bf16*)(ws + WS_W13T))
#define EGU ((bf16*)(ws + WS_EGU))
#define EDN ((bf16*)(ws + WS_EDN))
#define XN ((bf16*)(ws + WS_XN))
#define QKV ((bf16*)(ws + WS_QKV))
#define Ubuf ((bf16*)(ws + WS_UBUF))
#define Sloc ((float*)(ws + WS_SLOC))
#define Gb ((bf16*)(ws + WS_G))
#define Ob ((bf16*)(ws + WS_O))
#define concat ((bf16*)(ws + WS_CONCAT))
#define Hbuf ((bf16*)(ws + WS_HBUF))
#define Yb ((bf16*)(ws + WS_Y))
#define X1 ((float*)(ws + WS_X1))
#define elist ((int*)(ws + WS_ELIST))
#define counts (F.ctl + CW_COUNTS)
#define cursor (F.ctl + CW_CURSOR)
    const int gw = F.vcu * NWAVES + F.wave, NGW = F.G * NWAVES, lane = F.lane;
    LAS unsigned char* ring = F.lds + RING_OFF;

    PH(0) {
        P0In I{args.in[1], args.in[2], args.in[3], args.in[5], args.in[6], args.in[20], args.in[23], args.in[25], args.in[26], args.in[27], args.in[28], args.in[29], args.in[30],
               args.in[12], args.in[13], args.in[14], args.in[15], args.in[16], args.in[17], args.in[18]};
        p0_prologue(F, I, ws, args.variant);
    }
    SEAM(0);
    PH(1) { if (gw < 96) { const int j = gw * 64 + lane; const float* mp = (const float*)(ws + WS_MODP); float s0 = mp[j], s1 = mp[6 * D_ + j];
#pragma unroll
            for (int q = 1; q < 16; ++q) { s0 += mp[(size_t)(q * 2) * 6 * D_ + j]; s1 += mp[(size_t)(q * 2 + 1) * 6 * D_ + j]; }
            mod[j] = s0; mod[6 * D_ + j] = s1; }
        norm_mod_rows<16>(F, x, args.in[4], (const float*)(ws + WS_MODP), 0, D_, XN); }
    SEAM(1);
    PH(2) { GridOrder S{(const char*)XN, (const char*)Win_t, 1024, 1024, 64, 8, 512, F.G, (int)blockIdx.x};
        EpiProj E{QKV, Ubuf, attn_body::C2};
        pg8::gemm_phase<EpiProj, GridOrder, false, true>(ring, 1024, 1024, 1024, S, E); }
    SEAM(2);
    PH(3) {
        const int xg = F.vcu >> 5, xl = F.vcu & 31;
        if (xl < 8) { const int sg = xg * 8 + xl;
            gu32* sbar = F.ctl + CW_SUB;
            { GroupOrder S{(const char*)Ubuf, (const char*)W2t, 384, 256, 128, 64, sg}; EpiSloc E{Sloc};
              pg8::gemm_phase<EpiSloc, GroupOrder, false, false>(ring, 256, 384, 256, S, E); }
            sub_barrier(F, sbar, 64u);
            { const int b = sg >> 5, g = sg & 31, p = lane, w = F.wave;
            const float lr = lamT[(g * 64 + p) * 2], li = lamT[(g * 64 + p) * 2 + 1];
            const size_t row0 = (size_t)g * 1024 + b * 512 + w * 64;
            pg8::f32x2 v[64];
            { const char* lp = (const char*)(Sloc + row0 * 128 + 2 * p);
#pragma unroll
              for (int j = 0; j < 64; ++j) { v[j] = *(const GAS pg8::f32x2*)(lp + (j & 7) * 512); if ((j & 7) == 7) { lp += 4096; asm volatile("" : "+v"(lp)); } } }
            float tr = 0.f, ti = 0.f;
#pragma unroll
            for (int j = 0; j < 64; ++j) { const float nr = lr * tr - li * ti + v[j].x, ni = lr * ti + li * tr + v[j].y; tr = nr; ti = ni; }
            LAS float* xs = (LAS float*)ring;
            xs[(w * 64 + p) * 2] = tr; xs[(w * 64 + p) * 2 + 1] = ti;
            float Lr = lr, Li = li;
#pragma unroll
            for (int q = 0; q < 6; ++q) { const float nr = Lr * Lr - Li * Li, ni = 2.f * Lr * Li; Lr = nr; Li = ni; }
            __syncthreads();
            float sr = 0.f, si = 0.f;
            for (int w2 = 0; w2 < w; ++w2) { const float xr = xs[(w2 * 64 + p) * 2], xi = xs[(w2 * 64 + p) * 2 + 1]; const float nr = Lr * sr - Li * si + xr, ni = Lr * si + Li * sr + xi; sr = nr; si = ni; }
            { char* sp = (char*)(Ubuf + row0 * 384 + 256 + 2 * p);
#pragma unroll
              for (int j = 0; j < 64; ++j) { *(GAS unsigned*)(sp + (j & 3) * 768) = pk2(sr, si); if ((j & 3) == 3) { sp += 3072; asm volatile("" : "+v"(sp)); }
                const float nr = lr * sr - li * si + v[j].x, ni = lr * si + li * sr + v[j].y; sr = nr; si = ni; } }
            __syncthreads();
        }
            sub_barrier(F, sbar, 128u);
            { GroupOrder S{(const char*)Ubuf, (const char*)W13t, 384, 384, 128, 64, sg}; EpiSsm2 E{Ubuf, args.in[19], Gb};
              pg8::gemm_phase<EpiSsm2, GroupOrder, false, false>(ring, 384, 384, 384, S, E); }
            sub_barrier(F, sbar, 192u);
            { GluOrder S{(const char*)Gb, (const char*)Wglu_t, sg}; EpiGlu E{Gb, args.in[21], concat};
              pg8::gemm_phase<EpiGlu, GluOrder, false, false>(ring, 512, 512, 512, S, E); }
        }
        const P0In I{args.in[1], args.in[2], args.in[3], args.in[5], args.in[6], args.in[20], args.in[23], args.in[25], args.in[26], args.in[27], args.in[28], args.in[29], args.in[30],
                     args.in[12], args.in[13], args.in[14], args.in[15], args.in[16], args.in[17], args.in[18]};
        if (xl >= 8 && xl < 8 + NCONV && !(args.variant & 256)) conv_queues(I, ws, F.ctl + CW_CQ, xg, lane);
        { const attn_body::AttnTensors AT{(const attn_body::bf16*)QKV, (attn_body::bf16*)Ob};
          const attn_body::QueueOrder S{F.ctl + CW_AQ + 64 * xg, (LAS int*)(F.lds + MISC_OFF + 64), xg};
          attn_body::attn_phase<attn_body::QueueOrder>((char*)lds + RING_OFF, AT, S); }
        if (!(args.variant & 256)) conv_queues(I, ws, F.ctl + CW_CQ, xg, lane);
    }
    SEAM(7);
    PH(8) {
        const float* lq1 = args.in[7]; const float* lk1 = args.in[8]; const float* lq2 = args.in[9]; const float* lk2 = args.in[10]; const float* subg = args.in[11];
        const float s1 = wave_sum(lq1[lane] * lk1[lane]), s2 = wave_sum(lq2[lane] * lk2[lane]);
        const float lam_init = 0.2f, lam = __expf(s1) - __expf(s2) + lam_init;
        const float g0 = subg[2 * lane] * (1.f - lam_init), g1 = subg[2 * lane + 1] * (1.f - lam_init);
        for (int m = gw; m < M_; m += NGW) {
            const GAS unsigned* orow = (const GAS unsigned*)(Ob + (size_t)m * 1024); GAS unsigned* crow = (GAS unsigned*)(concat + (size_t)m * 1024);
            unsigned a[4], b[4];
#pragma unroll
            for (int h = 0; h < 4; ++h) { a[h] = orow[h * 128 + lane]; b[h] = orow[h * 128 + 64 + lane]; }
#pragma unroll
            for (int h = 0; h < 4; ++h) { const float v0 = bflo(a[h]) - lam * bflo(b[h]), v1 = bfhi(a[h]) - lam * bfhi(b[h]);
                const float r = rsqrtf(wave_sum(v0 * v0 + v1 * v1) * (1.f / 128.f) + SUBLN_EPS);
                crow[h * 64 + lane] = pk2(v0 * r * g0, v1 * r * g1); }
        }
    }
    SEAM(8);
    PH(9) { GridOrder S{(const char*)concat, (const char*)Wout_t, 1024, 1024, 64, 4, 256, F.G, (int)blockIdx.x};
        EpiRes E{x, mod, X1};
        pg8::gemm_phase<EpiRes, GridOrder, false, false>(ring, 1024, 1024, 1024, S, E); }
    SEAM(9);
    PH(10) norm_mod_rows<1>(F, X1, args.in[22], mod, 3 * D_, 4 * D_, XN, ws + WS_XN8);
    SEAM(10);
    PH(11) { GridOrder S{(const char*)XN, (const char*)Wr_t, 1024, 1024, 64, 1, 64, F.G, (int)blockIdx.x};
        EpiLogits E{logits};
        pg8::gemm_phase<EpiLogits, GridOrder, false, false>(ring, 1024, 1024, 1024, S, E);
        if ((int)blockIdx.x >= 64) { const P0In I{args.in[1], args.in[2], args.in[3], args.in[5], args.in[6], args.in[20], args.in[23], args.in[25], args.in[26], args.in[27], args.in[28], args.in[29], args.in[30],
                         args.in[12], args.in[13], args.in[14], args.in[15], args.in[16], args.in[17], args.in[18]};
            conv8_range(I, ws, C8_P2, NB8, ((int)blockIdx.x - 64) * NWAVES + F.wave, (F.G - 64) * NWAVES, lane); } }
    SEAM(11);
#ifdef DBG_ROUTE
    PH(12) { for (int m = gw; m < M_; m += NGW) { nv::route_token<CSTR>(logits + (size_t)m * NE, args.in[24], lane, idx + m * 8, rw + m * 8, (unsigned*)counts);
            nv::route_token_dpp<CSTR, false>(logits + (size_t)m * NE, args.in[24], lane, slotpos + m * 8, (float*)sorted + m * 8, (unsigned*)counts);
            if (lane < DBG_ROUTE && slotpos[m * 8 + lane] != idx[m * 8 + lane]) atomicAdd((unsigned*)(F.ctl + 200000), 1u); } }
#else
    PH(12) {
        LAS unsigned* lcnt = (LAS unsigned*)(F.lds + RING_OFF); LAS int* stash = (LAS int*)(F.lds + RING_OFF + 1024) + F.wave * 64;
        for (int mb = 0; mb < M_; mb += NGW * 8) {
            __syncthreads();
            if (F.tid < 256) lcnt[F.tid] = 0u;
            __syncthreads();
#pragma unroll 1
            for (int t = 0; t < 8; ++t) { const int m = mb + t * NGW + gw; if (m >= M_) break;
                nv::route_token_dpp<CSTR, false>(logits + (size_t)m * NE, args.in[24], lane, idx + m * 8, rw + m * 8, nullptr);
                if (lane < 8) { const int e = idx[m * 8 + lane]; const unsigned lr = __hip_atomic_fetch_add(lcnt + e, 1u, __ATOMIC_RELAXED, __HIP_MEMORY_SCOPE_WORKGROUP); stash[t * 8 + lane] = e | (int)(lr << 8); }
                if (lane == 8) elist[NE * 16384 + m] = m; }
            __syncthreads();
            if (F.tid < 256) { const unsigned c = lcnt[F.tid]; if (c) lcnt[F.tid] = __hip_atomic_fetch_add(counts + F.tid * CSTR, c, RLX_AGENT); }
            __syncthreads();
            { const int t = lane >> 3, m = mb + t * NGW + gw;
              if (m < M_) { const int p = stash[lane], e = p & 255, rk = (int)lcnt[e] + (p >> 8); slotpos[m * 8 + (lane & 7)] = rk; elist[e * 16384 + rk] = m; } }
        }
    }
#endif
    SEAM(12);
    PH(14) { const int ntot = build_expert_tables<2>(F, counts, 16);
        ExpertOrder8 S{(const LAS int*)(F.lds + TAB_OFFS), (const LAS int*)(F.lds + TAB_DESC), (const char*)(ws + WS_XN8), (const char*)(ws + WS_EGU), elist, F.G, F.vcu, ntot};
        EpiGateUp8 E{(unsigned char*)Hbuf};
        pg8::gemm_phase<EpiGateUp8, ExpertOrder8, true, true, true>(ring, 512, 512, 512, S, E); }
    SEAM(14);
    PH(15) { const int ntot = build_expert_tables<4>(F, counts, 32);
        ExpertOrderD8 S{(const LAS int*)(F.lds + TAB_OFFS), (const LAS int*)(F.lds + TAB_DESC), (const char*)Hbuf, (const char*)EDN, F.G, F.vcu, ntot};
        EpiDown8 E{(unsigned char*)Yb};
        int Kd = 128; asm volatile("" : "+s"(Kd));
        pg8::gemm_phase<EpiDown8, ExpertOrderD8, false, true, true>(ring, Kd, 128, 128, S, E); }
    SEAM(15);
    PH(16) {
        const float* fg = args.in[31]; const unsigned char* Y8 = (const unsigned char*)Yb;
        (void)build_expert_tables<1>(F, counts, 0);
        const LAS int* offs = (const LAS int*)(F.lds + TAB_OFFS);
        for (int m0 = gw * 8; m0 < M_; m0 += NGW * 8) {
            const int spv = offs[idx[m0 * 8 + lane]] + slotpos[m0 * 8 + lane]; const float wvv = rw[m0 * 8 + lane] * 0.0625f;
            const int b = m0 >> 13; const float* g2 = mod + b * 6 * D_ + 5 * D_;
            f32x4 gg2[4], fgg[4];
#pragma unroll
            for (int q4 = 0; q4 < 4; ++q4) { gg2[q4] = *(const GAS f32x4*)(g2 + 16 * lane + 4 * q4); fgg[q4] = *(const GAS f32x4*)(fg + 16 * lane + 4 * q4); }
#pragma unroll 2
            for (int t = 0; t < 8; ++t) { const int m = m0 + t;
                v4u yq[9]; float wk[9];
                yq[0] = *(const GAS v4u*)(Y8 + (size_t)(NSLOT + m) * 1024 + 16 * lane); wk[0] = 0.0625f;
#pragma unroll
                for (int k = 0; k < 8; ++k) { const int pos = __builtin_amdgcn_readlane(spv, t * 8 + k); wk[k + 1] = __int_as_float(__builtin_amdgcn_readlane(__float_as_int(wvv), t * 8 + k));
                    yq[k + 1] = *(const GAS v4u*)(Y8 + (size_t)pos * 1024 + 16 * lane); }
                f32x4 x1[4];
#pragma unroll
                for (int q4 = 0; q4 < 4; ++q4) x1[q4] = *(const GAS f32x4*)(X1 + (size_t)m * D_ + 16 * lane + 4 * q4);
                float accv[16];
#pragma unroll
                for (int i = 0; i < 16; ++i) accv[i] = 0.f;
#pragma unroll
                for (int k = 0; k < 9; ++k)
#pragma unroll
                    for (int d_ = 0; d_ < 4; ++d_) { const pg8::f32x2 lo_ = __builtin_amdgcn_cvt_pk_f32_fp8((int)yq[k][d_], false), hi_ = __builtin_amdgcn_cvt_pk_f32_fp8((int)yq[k][d_], true);
                        accv[4 * d_] += wk[k] * lo_[0]; accv[4 * d_ + 1] += wk[k] * lo_[1]; accv[4 * d_ + 2] += wk[k] * hi_[0]; accv[4 * d_ + 3] += wk[k] * hi_[1]; }
                float xv[16]; float s = 0.f;
#pragma unroll
                for (int q4 = 0; q4 < 4; ++q4)
#pragma unroll
                    for (int e = 0; e < 4; ++e) { const float v = x1[q4][e] + gg2[q4][e] * accv[q4 * 4 + e]; xv[q4 * 4 + e] = v; s += v * v; }
                const float rstd = rsqrtf(wave_sum(s) * (1.f / D_) + NORM_EPS);
#pragma unroll
                for (int q4 = 0; q4 < 4; ++q4) { f32x4 o; o.x = xv[q4 * 4 + 0] * rstd * fgg[q4].x; o.y = xv[q4 * 4 + 1] * rstd * fgg[q4].y; o.z = xv[q4 * 4 + 2] * rstd * fgg[q4].z; o.w = xv[q4 * 4 + 3] * rstd * fgg[q4].w;
                    *(GAS f32x4*)(out + (size_t)m * D_ + 16 * lane + 4 * q4) = o; }
            }
        }
    }
#undef IN
#undef SEAM
#undef mod
#undef lamT
#undef idx
#undef rw
#undef slotpos
#undef sorted
#undef logits
#undef Win_t
#undef Wout_t
#undef Wglu_t
#undef Wr_t
#undef W2t
#undef W13t
#undef EGU
#undef EDN
#undef XN
#undef QKV
#undef Ubuf
#undef Sloc
#undef Gb
#undef Ob
#undef concat
#undef Hbuf
#undef Yb
#undef X1
#undef elist
#undef counts
#undef cursor
}
}
#ifndef MK_PER_PHASE
#define MK_PER_PHASE 0
#endif
extern "C" void kernel_launch(void* const* d_in, const int* in_sizes, int n_in, void* d_out, int out_size, void* d_ws, size_t ws_size, hipStream_t stream) {
    using namespace mk;
    static int grid = 0;
    if (grid == 0) {
        if (n_in != 32 || in_sizes[0] != M_ * D_ || out_size != M_ * D_ || ws_size < WS_END) { fprintf(stderr, "kernel_launch: unexpected shapes (n_in %d, ws %zu < %zu?)\n", n_in, ws_size, (size_t)WS_END); grid = -1; return; }
        int dev = 0, cus = 0, per_cu = 0;
        if (hipGetDevice(&dev) != hipSuccess || hipDeviceGetAttribute(&cus, hipDeviceAttributeMultiprocessorCount, dev) != hipSuccess) { grid = -1; return; }
        if (hipFuncSetAttribute((const void*)mega_fwd, hipFuncAttributeMaxDynamicSharedMemorySize, LDS_BYTES) != hipSuccess) { fprintf(stderr, "kernel_launch: hipFuncSetAttribute failed\n"); grid = -1; return; }
        if (hipOccupancyMaxActiveBlocksPerMultiprocessor(&per_cu, (const void*)mega_fwd, NWAVES * 64, LDS_BYTES) != hipSuccess || per_cu < 1) { fprintf(stderr, "kernel_launch: occupancy query says %d blocks per CU\n", per_cu); (void)hipGetLastError(); grid = -1; return; }
        grid = cus;
        if (grid != 256) fprintf(stderr, "kernel_launch: note: %d CUs\n", grid);
    }
    if (grid < 0) return;
    (void)hipMemsetAsync((char*)d_ws + WS_CTL, 0, CTL_ZERO_BYTES, stream);
    Args a{};
    for (int i = 0; i < 32; ++i) a.in[i] = (const float*)d_in[i];
    a.out = (float*)d_out; a.ws = (unsigned char*)d_ws;
#if MK_PER_PHASE
    for (int k = 0; k < NPHASE; ++k) {
#ifdef EXP_F32_ROUTER
        if (k == 11) { float* XNf = (float*)((char*)d_ws + WS_QKV); float* modp = (float*)((char*)d_ws + WS_MOD); float* lg = (float*)((char*)d_ws + WS_LOGITS);
            nv::k_norm_mod<<<M_, 256, 0, stream>>>((const float*)d_out, (const float*)d_in[22], modp, 3 * D_, 4 * D_, XNf);
            nv::GemmArgs g{}; g.A = XNf; g.gather = nullptr; g.B = (const float*)d_in[23]; g.seg = nullptr; g.strideB = 0; g.lda = 1024; g.ldb = 256; g.M = M_; g.N = 256; g.K = 1024; g.pad = 0;
            nv::k_gemm<<<dim3(4, M_ / 64, 1), 256, 0, stream>>>(g, nv::EpiStore{lg, 256, 0});
            continue; }
#endif
        a.ph_lo = k; a.ph_hi = k + 1;
#ifndef HOST_REPEAT_MASK
#define HOST_REPEAT_MASK 0
#endif
#ifndef HOST_VARIANT
#define HOST_VARIANT 0
#endif
        for (int rep = 0; rep < 1 + ((HOST_REPEAT_MASK >> k) & 1); ++rep) { a.variant = (rep == 0 && ((HOST_REPEAT_MASK >> k) & 1)) ? HOST_VARIANT : 0; if (rep && k == 12) (void)hipMemsetAsync((char*)d_ws + CW_COUNTS * 4, 0, 256 * 64 * 4, stream); if (rep && k == 13) (void)hipMemsetAsync((char*)d_ws + CW_CURSOR * 4, 0, 256 * 64 * 4, stream); if (rep && k == 3) (void)hipMemsetAsync((char*)d_ws + CW_SUB * 4, 0, 64 * 40 * 4, stream);
            hipLaunchKernelGGL(mega_fwd, dim3(grid), dim3(NWAVES * 64), LDS_BYTES, stream, a); } }
#else
    a.ph_lo = 0; a.ph_hi = NPHASE;
    void* kargs[] = {&a};
    hipError_t e = hipLaunchCooperativeKernel((const void*)mega_fwd, dim3(grid), dim3(NWAVES * 64), kargs, LDS_BYTES, stream);
    if (e != hipSuccess) fprintf(stderr, "kernel_launch: cooperative launch failed: %s\n", hipGetErrorString(e));
#endif
}
```
